# Optimizing an MI355X kernel written in HIP

```python
import jax, jax.numpy as jnp
from jax import lax
import numpy as np

D_MODEL = 1024
BATCH = 4
SEQ = 8192
DEPTH = 2

CHUNK = 64
N_BRANCH = 4
BRANCH = D_MODEL // N_BRANCH
D_MIX = N_BRANCH * BRANCH
EPS = 1e-6

CONV_A_WIDTH = 3
CONV_A_GROUPS = 4
GLA_HEADS = 4
GLA_DK = BRANCH // 2
GLA_DV = BRANCH
GLA_GATE_RANK = 16
GLA_TAU = 16.0
POOL_WINDOWS = (2, 4, 8, 16)
POOL_GROUP = BRANCH // len(POOL_WINDOWS)
SSD_HEAD_DIM = 64
SSD_HEADS = BRANCH // SSD_HEAD_DIM
SSD_GROUPS = 2
SSD_STATE = 128
SSD_CONV = 4
SSD_XBC = BRANCH + 2 * SSD_GROUPS * SSD_STATE

PROJ_SPLITS = (BRANCH, BRANCH, BRANCH, BRANCH,
               GLA_DK, GLA_DK, GLA_DV, GLA_GATE_RANK, GLA_DV,
               BRANCH, BRANCH,
               BRANCH, SSD_XBC, SSD_HEADS)
D_PROJ = sum(PROJ_SPLITS)

kernel_name = 'hybrid_parallel_conv_gla_pool_ssd'


def _rmsnorm(x, w):
    xf = x.astype(jnp.float32)
    y = xf * lax.rsqrt(jnp.mean(xf * xf, axis=-1, keepdims=True) + EPS)
    return (y * w.astype(jnp.float32)).astype(x.dtype)


def _causal_depthwise_conv(u, w):
    k = w.shape[0]
    return lax.conv_general_dilated(
        u, w[:, None, :].astype(u.dtype), window_strides=(1,), padding=[(k - 1, 0)],
        dimension_numbers=('NWC', 'WIO', 'NWC'), feature_group_count=u.shape[-1])


def _chunk_states(decay, update):
    def step(s, inp):
        a_c, u_c = inp
        s = a_c * s + u_c
        return s, s
    init = jnp.zeros_like(update[:, 0])
    _, states = lax.scan(step, init, (jnp.moveaxis(decay, 1, 0), jnp.moveaxis(update, 1, 0)))
    return jnp.moveaxis(states, 0, 1)


def _conv_mixer(h, bg, cg, z, conv_w):
    y = bg * _causal_depthwise_conv(cg * h, conv_w)
    return y * jax.nn.silu(z)


def _gla_mixer(q, k, v, g_lr, z, gate_w, gate_b, norm_w):
    b, l, _ = q.shape
    nc = l // CHUNK
    dk = GLA_DK // GLA_HEADS
    dv = GLA_DV // GLA_HEADS
    f32 = jnp.float32
    qc = q.astype(f32).reshape(b, nc, CHUNK, GLA_HEADS, dk) * (dk ** -0.5)
    kc = k.astype(f32).reshape(b, nc, CHUNK, GLA_HEADS, dk)
    vc = v.astype(f32).reshape(b, nc, CHUNK, GLA_HEADS, dv)
    log_a = jax.nn.log_sigmoid((g_lr @ gate_w + gate_b).astype(f32)) / GLA_TAU
    log_a = log_a.reshape(b, nc, CHUNK, GLA_HEADS, dk)
    cum = jnp.cumsum(log_a, axis=2)
    total = cum[:, :, -1]
    k_dec = kc * jnp.exp(total[:, :, None] - cum)
    upd = jnp.einsum('bnchk,bnchv->bnhkv', k_dec, vc)
    states = _chunk_states(jnp.exp(total)[..., None], upd)
    o = jnp.einsum('bnchk,bnhkv->bnchv', qc, states)
    o = _rmsnorm(o, norm_w).reshape(b, l, GLA_DV)
    return (o * jax.nn.silu(z.astype(f32))).astype(q.dtype)


def _pool_mixer(u, z, pool_w, pool_scale):
    b, l, _ = u.shape
    f32 = jnp.float32
    uf = u.astype(f32)
    cs = jnp.pad(jnp.cumsum(uf, axis=1), ((0, 0), (1, 0), (0, 0)))
    pos = jnp.arange(l)
    outs = []
    for gi, win in enumerate(POOL_WINDOWS):
        sl = slice(gi * POOL_GROUP, (gi + 1) * POOL_GROUP)
        cg = cs[:, :, sl]
        prev = jnp.pad(cg, ((0, 0), (win - 1, 0), (0, 0)))[:, :l]
        cnt = jnp.minimum(pos + 1, win).astype(f32)[None, :, None]
        outs.append((cg[:, 1:] - prev) / cnt - uf[:, :, sl])
    pooled = jnp.stack(outs, axis=2)
    mixed = jnp.einsum('blgc,gcd->blgd', pooled, pool_w.astype(f32)).reshape(b, l, BRANCH)
    return (pool_scale.astype(f32) * mixed * jax.nn.silu(z.astype(f32))).astype(u.dtype)


def _ssd_mixer(xbc, dt, z, conv_w, conv_b, dt_bias, a_log, d_skip, norm_w):
    b, l, _ = xbc.shape
    nc = l // CHUNK
    hpg = SSD_HEADS // SSD_GROUPS
    f32 = jnp.float32
    xbc = jax.nn.silu(_causal_depthwise_conv(xbc, conv_w) + conv_b).astype(f32)
    xs, bm, cm = jnp.split(xbc, [BRANCH, BRANCH + SSD_GROUPS * SSD_STATE], axis=-1)
    xs = xs.reshape(b, nc, CHUNK, SSD_GROUPS, hpg, SSD_HEAD_DIM)
    bm = bm.reshape(b, nc, CHUNK, SSD_GROUPS, SSD_STATE)
    cm = cm.reshape(b, nc, CHUNK, SSD_GROUPS, SSD_STATE)
    dt = jax.nn.softplus(dt.astype(f32) + dt_bias.astype(f32)).reshape(b, nc, CHUNK, SSD_GROUPS, hpg)
    a = -jnp.exp(a_log.astype(f32)).reshape(SSD_GROUPS, hpg)
    cum = jnp.cumsum(dt * a, axis=2)
    total = cum[:, :, -1]
    w = jnp.exp(total[:, :, None] - cum) * dt
    upd = jnp.einsum('bncgs,bncgh,bncghp->bnghps', bm, w, xs)
    states = _chunk_states(jnp.exp(total)[..., None, None], upd)
    y = jnp.einsum('bncgs,bnghps->bncghp', cm, states)
    y = y + d_skip.astype(f32).reshape(SSD_GROUPS, hpg)[:, :, None] * xs
    y = y.reshape(b, l, BRANCH)
    y = _rmsnorm(y * jax.nn.silu(z.astype(f32)), norm_w)
    return y.astype(z.dtype)


def setup_inputs(seed: int = 0) -> dict:
    key = jax.random.key(seed)
    ks = jax.random.split(key, 20)
    f32 = jnp.float32
    nrm = lambda k, shape, s: jax.random.normal(k, shape, f32) * s
    x = jax.random.normal(ks[0], (BATCH, SEQ, D_MODEL), f32)
    norm_w = 1.0 + nrm(ks[1], (DEPTH, D_MODEL), 0.02)
    w_in = nrm(ks[2], (DEPTH, D_MODEL, D_PROJ), D_MODEL ** -0.5)
    conv_a_w = nrm(ks[3], (DEPTH, CONV_A_WIDTH, BRANCH), CONV_A_WIDTH ** -0.5)
    gla_gate_w = nrm(ks[4], (DEPTH, GLA_GATE_RANK, GLA_DK), GLA_GATE_RANK ** -0.5)
    gla_gate_b = nrm(ks[5], (DEPTH, GLA_DK), 0.1)
    gla_norm_w = 1.0 + nrm(ks[6], (DEPTH, GLA_DV // GLA_HEADS), 0.02)
    pool_w = nrm(ks[7], (DEPTH, len(POOL_WINDOWS), POOL_GROUP, POOL_GROUP), POOL_GROUP ** -0.5)
    pool_scale = 1.0 + nrm(ks[8], (DEPTH, BRANCH), 0.1)
    ssd_conv_w = nrm(ks[9], (DEPTH, SSD_CONV, SSD_XBC), SSD_CONV ** -0.5)
    ssd_conv_b = nrm(ks[10], (DEPTH, SSD_XBC), 0.01)
    dt0 = jnp.exp(jax.random.uniform(ks[11], (DEPTH, SSD_HEADS), f32, np.log(1e-3), np.log(1e-1)))
    ssd_dt_bias = dt0 + jnp.log(-jnp.expm1(-dt0))
    ssd_a_log = jnp.log(jax.random.uniform(ks[12], (DEPTH, SSD_HEADS), f32, 1.0, 16.0))
    ssd_d = 1.0 + nrm(ks[13], (DEPTH, SSD_HEADS), 0.1)
    ssd_norm_w = 1.0 + nrm(ks[14], (DEPTH, BRANCH), 0.02)
    w_out = nrm(ks[15], (DEPTH, D_MIX, D_MODEL), D_MIX ** -0.5)
    final_norm_w = 1.0 + nrm(ks[16], (D_MODEL,), 0.02)
    return {'x': x, 'norm_w': norm_w, 'w_in': w_in, 'conv_a_w': conv_a_w,
            'gla_gate_w': gla_gate_w, 'gla_gate_b': gla_gate_b, 'gla_norm_w': gla_norm_w,
            'pool_w': pool_w, 'pool_scale': pool_scale,
            'ssd_conv_w': ssd_conv_w, 'ssd_conv_b': ssd_conv_b, 'ssd_dt_bias': ssd_dt_bias,
            'ssd_a_log': ssd_a_log, 'ssd_d': ssd_d, 'ssd_norm_w': ssd_norm_w,
            'w_out': w_out, 'final_norm_w': final_norm_w}


def reference(x, norm_w, w_in, conv_a_w, gla_gate_w, gla_gate_b, gla_norm_w, pool_w, pool_scale,
              ssd_conv_w, ssd_conv_b, ssd_dt_bias, ssd_a_log, ssd_d, ssd_norm_w, w_out, final_norm_w):
    split_idx = [int(i) for i in np.cumsum(PROJ_SPLITS)[:-1]]
    for layer in range(DEPTH):
        h = _rmsnorm(x, norm_w[layer])
        proj = h @ w_in[layer]
        (a_h, a_b, a_c, a_z, g_q, g_k, g_v, g_lr, g_z, p_u, p_z, s_z, s_xbc, s_dt) = jnp.split(proj, split_idx, axis=-1)
        y_a = _conv_mixer(a_h, a_b, a_c, a_z, conv_a_w[layer])
        y_b = _gla_mixer(g_q, g_k, g_v, g_lr, g_z, gla_gate_w[layer], gla_gate_b[layer], gla_norm_w[layer])
        y_c = _pool_mixer(p_u, p_z, pool_w[layer], pool_scale[layer])
        y_d = _ssd_mixer(s_xbc, s_dt, s_z, ssd_conv_w[layer], ssd_conv_b[layer], ssd_dt_bias[layer],
                         ssd_a_log[layer], ssd_d[layer], ssd_norm_w[layer])
        mix = jnp.concatenate([y_a, y_b, y_c, y_d], axis=-1)
        x = x + mix @ w_out[layer]
    return _rmsnorm(x, final_norm_w)
```

```cpp
#include <hip/hip_runtime.h>
#include <cstdio>
#include <cstdint>

typedef unsigned short bf16;
constexpr int T = 32768, D = 1024, SEQ = 8192, NB = 4, CH = 64, NCHUNK = 512, NCB = 128;
constexpr int NP = 3584;
constexpr int DPROJ = 3348;
constexpr float EPS = 1e-6f;
constexpr int C_AH = 0, C_AB = 256, C_AC = 512, C_AZ = 768, C_Q = 1024, C_K = 1152, C_V = 1280, C_GZ = 1536,
              C_PU = 1792, C_PZ = 2048, C_SZ = 2304, C_XS = 2560, C_BM = 2816, C_CM = 3072, C_GATE = 3328, C_DT = 3456;
constexpr int NSTATE = 40960;
constexpr size_t MiB = 1u << 20;
constexpr size_t WS_CTL = 0, WS_W1T = 1 * MiB, WS_W2T = 15 * MiB, WS_PWT = 19 * MiB, WS_RSS = 20 * MiB, WS_DECG = 21 * MiB, WS_DECS = 21 * MiB + 512 * 1024,
                 WS_XB = 32 * MiB, WS_MIX = 96 * MiB, WS_UPD = 160 * MiB, WS_ST = 240 * MiB, WS_PROJ = 280 * MiB, WS_END = 504 * MiB;

__device__ __forceinline__ float bf2f(bf16 v) { return __uint_as_float((unsigned)v << 16); }
__device__ __forceinline__ bf16 f2bf(float f) { unsigned u = __float_as_uint(f); return (bf16)((u + 0x7fffu + ((u >> 16) & 1u)) >> 16); }
__device__ __forceinline__ float silu_f(float x) { return x / (1.f + __expf(-x)); }
__device__ __forceinline__ float softplus_f(float x) { return fmaxf(x, 0.f) + log1pf(__expf(-fabsf(x))); }
__device__ __forceinline__ float logsigmoid_f(float x) { return fminf(x, 0.f) - log1pf(__expf(-fabsf(x))); }

__global__ void k_pro_w1(const float* w_in, const float* norm_w, const float* gate_w, bf16* W1T) {
    size_t idx = (size_t)blockIdx.x * blockDim.x + threadIdx.x;
    if (idx >= (size_t)2 * D * NP) return;
    int n = idx % NP; int k = (idx / NP) % D; int l = idx / ((size_t)NP * D);
    const float* W = w_in + (size_t)l * D * DPROJ + (size_t)k * DPROJ;
    float v;
    if (n < 1536) v = W[n];
    else if (n < 3328) v = W[n + 16];
    else if (n < 3456) { float s = 0.f; for (int r = 0; r < 16; ++r) s += W[1536 + r] * gate_w[(size_t)l * 16 * 128 + r * 128 + (n - 3328)]; v = s; }
    else if (n < 3460) v = W[3344 + (n - 3456)];
    else v = 0.f;
    v *= norm_w[l * D + k];
    W1T[(size_t)l * NP * D + (size_t)n * D + k] = f2bf(v);
}
__global__ void k_pro_w2(const float* w_out, bf16* W2T) {
    size_t idx = (size_t)blockIdx.x * blockDim.x + threadIdx.x;
    if (idx >= (size_t)2 * D * D) return;
    int n = idx % D; int k = (idx / D) % D; int l = idx / ((size_t)D * D);
    W2T[(size_t)l * D * D + (size_t)n * D + k] = f2bf(w_out[(size_t)l * D * D + (size_t)k * D + n]);
}
__global__ void k_pro_x(const float* x, bf16* XB, float* RSS) {
    int row = blockIdx.x * 4 + (threadIdx.x >> 6), lane = threadIdx.x & 63;
    const float* xr = x + (size_t)row * D; float s = 0.f;
    for (int j = lane; j < D; j += 64) { float v = xr[j]; s += v * v; XB[(size_t)row * D + j] = f2bf(v); }
    for (int o = 1; o < 64; o <<= 1) s += __shfl_xor(s, o);
    if (lane == 0) { RSS[row * 4 + 0] = s; RSS[row * 4 + 1] = 0.f; RSS[row * 4 + 2] = 0.f; RSS[row * 4 + 3] = 0.f; }
}
__global__ void k_rss(const float* x, float* RSS) {
    int row = blockIdx.x * 4 + (threadIdx.x >> 6), lane = threadIdx.x & 63;
    const float* xr = x + (size_t)row * D; float s = 0.f;
    for (int j = lane; j < D; j += 64) { float v = xr[j]; s += v * v; }
    for (int o = 1; o < 64; o <<= 1) s += __shfl_xor(s, o);
    if (lane == 0) { RSS[row * 4 + 0] = s; RSS[row * 4 + 1] = 0.f; RSS[row * 4 + 2] = 0.f; RSS[row * 4 + 3] = 0.f; }
}

template <int MODE>
__global__ void __launch_bounds__(256) k_gemm(const bf16* A, const bf16* Bt, int M, int N, int K, const float* RSS, bf16* PROJ, const float* xold, float* xout, bf16* XB) {
    __shared__ float sA[32][68];
    __shared__ float sB[32][68];
    const int tid = threadIdx.x, tx = tid & 15, ty = tid >> 4;
    const int m0 = blockIdx.y * 64, n0 = blockIdx.x * 64;
    float acc[4][4];
    for (int i = 0; i < 4; ++i) for (int j = 0; j < 4; ++j) acc[i][j] = 0.f;
    const int lr = tid >> 2, lk = (tid & 3) * 8;
    for (int k0 = 0; k0 < K; k0 += 32) {
        const bf16* ap = A + (size_t)(m0 + lr) * K + k0 + lk;
        const bf16* bp = Bt + (size_t)(n0 + lr) * K + k0 + lk;
        for (int j = 0; j < 8; ++j) { sA[lk + j][lr] = bf2f(ap[j]); sB[lk + j][lr] = bf2f(bp[j]); }
        __syncthreads();
        for (int kk = 0; kk < 32; ++kk) {
            float a[4], b[4];
            for (int i = 0; i < 4; ++i) { a[i] = sA[kk][ty * 4 + i]; b[i] = sB[kk][tx * 4 + i]; }
            for (int i = 0; i < 4; ++i) for (int j = 0; j < 4; ++j) acc[i][j] += a[i] * b[j];
        }
        __syncthreads();
    }
    for (int i = 0; i < 4; ++i) {
        const int row = m0 + ty * 4 + i;
        if (MODE == 1) {
            const float ss = RSS[row * 4 + 0] + RSS[row * 4 + 1] + RSS[row * 4 + 2] + RSS[row * 4 + 3];
            const float rstd = rsqrtf(ss * (1.f / D) + EPS);
            for (int j = 0; j < 4; ++j) PROJ[(size_t)row * N + n0 + tx * 4 + j] = f2bf(acc[i][j] * rstd);
        } else {
            for (int j = 0; j < 4; ++j) { const size_t o = (size_t)row * N + n0 + tx * 4 + j; const float v = xold[o] + acc[i][j]; xout[o] = v; XB[o] = f2bf(v); }
        }
    }
}

__global__ void k_conva(const bf16* PROJ, const float* cw  , bf16* MIX) {
    size_t idx = (size_t)blockIdx.x * blockDim.x + threadIdx.x;
    const int ch = idx & 255; const int t = idx >> 8; const int pos = t & (SEQ - 1);
    float acc = 0.f;
    for (int k = 0; k < 3; ++k) { const int d = 2 - k; if (pos - d >= 0) { const bf16* r = PROJ + (size_t)(t - d) * NP; acc += cw[k * 256 + ch] * (bf2f(r[C_AC + ch]) * bf2f(r[C_AH + ch])); } }
    const bf16* r = PROJ + (size_t)t * NP;
    const float y = bf2f(r[C_AB + ch]) * acc * silu_f(bf2f(r[C_AZ + ch]));
    MIX[(size_t)t * D + ch] = f2bf(y);
}
__global__ void __launch_bounds__(256) k_pool(const bf16* PROJ, const float* pw  , const float* pscale, bf16* MIX) {
    __shared__ float pooled[256];
    const int t = blockIdx.x, pos = t & (SEQ - 1), ch = threadIdx.x, g = ch >> 6;
    const int win = 2 << g;
    float s = 0.f; int cnt = 0;
    for (int d = 0; d < win; ++d) if (pos - d >= 0) { s += bf2f(PROJ[(size_t)(t - d) * NP + C_PU + ch]); ++cnt; }
    pooled[ch] = s / (float)cnt - bf2f(PROJ[(size_t)t * NP + C_PU + ch]);
    __syncthreads();
    const int dd = ch & 63; float m = 0.f;
    for (int c = 0; c < 64; ++c) m += pooled[g * 64 + c] * pw[(g * 64 + c) * 64 + dd];
    const float y = pscale[ch] * m * silu_f(bf2f(PROJ[(size_t)t * NP + C_PZ + ch]));
    MIX[(size_t)t * D + 512 + ch] = f2bf(y);
}
__global__ void __launch_bounds__(256) k_gla_local(const bf16* PROJ, const float* gate_b, float* UPD, float* DECG) {
    __shared__ float la[64][128];
    __shared__ float tot[128];
    const int chunk = blockIdx.x, t0 = chunk * CH, tid = threadIdx.x;
    for (int i = tid; i < 64 * 128; i += 256) { const int c = i >> 7, j = i & 127; la[c][j] = logsigmoid_f(bf2f(PROJ[(size_t)(t0 + c) * NP + C_GATE + j]) + gate_b[j]) * (1.f / 16.f); }
    __syncthreads();
    if (tid < 128) { float s = 0.f; for (int c = 0; c < 64; ++c) { s += la[c][tid]; la[c][tid] = s; } tot[tid] = s; DECG[chunk * 128 + tid] = __expf(s); }
    __syncthreads();
    for (int i = tid; i < 64 * 128; i += 256) { const int c = i >> 7, j = i & 127; la[c][j] = bf2f(PROJ[(size_t)(t0 + c) * NP + C_K + j]) * __expf(tot[j] - la[c][j]); }
    __syncthreads();
    for (int o = tid; o < 8192; o += 256) {
        const int h = o >> 11, vv = (o >> 5) & 63, kk = o & 31; float s = 0.f;
        for (int c = 0; c < 64; ++c) s += la[c][h * 32 + kk] * bf2f(PROJ[(size_t)(t0 + c) * NP + C_V + h * 64 + vv]);
        UPD[(size_t)chunk * NSTATE + o] = s;
    }
}
__device__ __forceinline__ float xbc_act(const bf16* PROJ, const float* cw  , const float* cb, int t, int pos, int j) {
    float a = cb[j];
    for (int k = 0; k < 4; ++k) { const int d = 3 - k; if (pos - d >= 0) a += cw[k * 768 + j] * bf2f(PROJ[(size_t)(t - d) * NP + C_XS + j]); }
    return silu_f(a);
}
__global__ void __launch_bounds__(256) k_ssd_local(const bf16* PROJ, const float* cw, const float* cb, const float* dt_bias, const float* a_log, float* UPD, float* DECS) {
    __shared__ float w[64][4];
    __shared__ float xsw[64][64];
    __shared__ float bm[64][128];
    const int chunk = blockIdx.x, t0 = chunk * CH, tid = threadIdx.x;
    if (tid < 4) {
        const int h = tid; const float a = -__expf(a_log[h]); float s = 0.f;
        for (int c = 0; c < 64; ++c) { const float dt = softplus_f(bf2f(PROJ[(size_t)(t0 + c) * NP + C_DT + h]) + dt_bias[h]); s += dt * a; w[c][h] = dt; xsw[c][h] = s; }
        for (int c = 0; c < 64; ++c) w[c][h] = __expf(s - xsw[c][h]) * w[c][h];
        DECS[chunk * 4 + h] = __expf(s);
    }
    __syncthreads();
    for (int h = 0; h < 4; ++h) {
        const int g = h >> 1;
        __syncthreads();
        for (int i = tid; i < 64 * 64; i += 256) { const int c = i >> 6, p = i & 63; const int t = t0 + c; xsw[c][p] = xbc_act(PROJ, cw, cb, t, t & (SEQ - 1), h * 64 + p) * w[c][h]; }
        if ((h & 1) == 0) for (int i = tid; i < 64 * 128; i += 256) { const int c = i >> 7, s = i & 127; const int t = t0 + c; bm[c][s] = xbc_act(PROJ, cw, cb, t, t & (SEQ - 1), 256 + g * 128 + s); }
        __syncthreads();
        for (int o = tid; o < 8192; o += 256) {
            const int p = o >> 7, s = o & 127; float acc = 0.f;
            for (int c = 0; c < 64; ++c) acc += xsw[c][p] * bm[c][s];
            UPD[(size_t)chunk * NSTATE + 8192 + h * 8192 + o] = acc;
        }
    }
}
__global__ void k_scan(const float* UPD, const float* DECG, const float* DECS, bf16* ST) {
    const int idx = blockIdx.x * blockDim.x + threadIdx.x;
    const int b = idx / NSTATE, e = idx % NSTATE; float s = 0.f;
    for (int c = 0; c < NCB; ++c) {
        const int chunk = b * NCB + c;
        const float dec = e < 8192 ? DECG[chunk * 128 + (e >> 11) * 32 + (e & 31)] : DECS[chunk * 4 + ((e - 8192) >> 13)];
        s = dec * s + UPD[(size_t)chunk * NSTATE + e];
        ST[(size_t)chunk * NSTATE + e] = f2bf(s);
    }
}
__global__ void __launch_bounds__(256) k_gla_out(const bf16* PROJ, const bf16* ST, const float* gnw  , bf16* MIX) {
    const int chunk = blockIdx.x, tid = threadIdx.x, c = tid >> 2, h = tid & 3, t = chunk * CH + c;
    float q[32];
#pragma unroll
    for (int kk = 0; kk < 32; ++kk) q[kk] = bf2f(PROJ[(size_t)t * NP + C_Q + h * 32 + kk]) * 0.17677669529663687f;
    const bf16* S = ST + (size_t)chunk * NSTATE + h * 2048;
    float ss = 0.f;
    for (int vv = 0; vv < 64; ++vv) { float o = 0.f;
_Pragma("unroll") for (int kk = 0; kk < 32; ++kk) o += q[kk] * bf2f(S[vv * 32 + kk]); ss += o * o; }
    const float rstd = rsqrtf(ss * (1.f / 64.f) + EPS);
    for (int vv = 0; vv < 64; ++vv) { float o = 0.f;
_Pragma("unroll") for (int kk = 0; kk < 32; ++kk) o += q[kk] * bf2f(S[vv * 32 + kk]);
        const float y = o * rstd * gnw[vv] * silu_f(bf2f(PROJ[(size_t)t * NP + C_GZ + h * 64 + vv]));
        MIX[(size_t)t * D + 256 + h * 64 + vv] = f2bf(y); }
}
__global__ void __launch_bounds__(256) k_ssd_out(const bf16* PROJ, const bf16* ST, const float* cw, const float* cb, const float* dsk, const float* snw  , bf16* MIX) {
    __shared__ float cm[64][128 + 1];
    __shared__ float red[64][4];
    const int chunk = blockIdx.x, tid = threadIdx.x, c = tid >> 2, h = tid & 3, t = chunk * CH + c, g = h >> 1;
    float ssum = 0.f;
    for (int pass = 0; pass < 2; ++pass) {
        float rstd = 0.f;
        if (pass == 1) { rstd = rsqrtf((red[c][0] + red[c][1] + red[c][2] + red[c][3]) * (1.f / 256.f) + EPS); }
        for (int gg = 0; gg < 2; ++gg) {
            __syncthreads();
            for (int i = tid; i < 64 * 128; i += 256) { const int cc = i >> 7, s = i & 127; const int tt = chunk * CH + cc; cm[cc][s] = xbc_act(PROJ, cw, cb, tt, tt & (SEQ - 1), 512 + gg * 128 + s); }
            __syncthreads();
            if (g == gg) {
                const bf16* S = ST + (size_t)chunk * NSTATE + 8192 + h * 8192;
                for (int p = 0; p < 64; ++p) {
                    float y = 0.f; for (int s = 0; s < 128; ++s) y += cm[c][s] * bf2f(S[p * 128 + s]);
                    y += dsk[h] * xbc_act(PROJ, cw, cb, t, t & (SEQ - 1), h * 64 + p);
                    y *= silu_f(bf2f(PROJ[(size_t)t * NP + C_SZ + h * 64 + p]));
                    if (pass == 0) ssum += y * y; else MIX[(size_t)t * D + 768 + h * 64 + p] = f2bf(y * rstd * snw[h * 64 + p]);
                }
            }
        }
        if (pass == 0) { red[c][h] = ssum; }
        __syncthreads();
    }
}
__global__ void k_final(float* out, const float* fw) {
    int row = blockIdx.x * 4 + (threadIdx.x >> 6), lane = threadIdx.x & 63;
    float* xr = out + (size_t)row * D; float s = 0.f; float v[16];
#pragma unroll
    for (int j = 0; j < 16; ++j) { v[j] = xr[lane + 64 * j]; s += v[j] * v[j]; }
    for (int o = 1; o < 64; o <<= 1) s += __shfl_xor(s, o);
    const float rstd = rsqrtf(s * (1.f / D) + EPS);
#pragma unroll
    for (int j = 0; j < 16; ++j) xr[lane + 64 * j] = v[j] * rstd * fw[lane + 64 * j];
}

extern "C" void kernel_launch(void* const* d_in, const int* in_sizes, int n_in, void* d_out, int out_size, void* d_ws, size_t ws_size, hipStream_t stream) {
    if (n_in != 17 || in_sizes[0] != T * D || out_size != T * D || ws_size < WS_END) { fprintf(stderr, "kernel_launch: unexpected shapes n_in %d in0 %d out %d ws %zu\n", n_in, n_in > 0 ? in_sizes[0] : -1, out_size, ws_size); return; }
    const float* x = (const float*)d_in[0]; const float* norm_w = (const float*)d_in[1]; const float* w_in = (const float*)d_in[2]; const float* conv_a_w = (const float*)d_in[3];
    const float* gate_w = (const float*)d_in[4]; const float* gate_b = (const float*)d_in[5]; const float* gla_norm_w = (const float*)d_in[6]; const float* pool_w = (const float*)d_in[7];
    const float* pool_scale = (const float*)d_in[8]; const float* ssd_conv_w = (const float*)d_in[9]; const float* ssd_conv_b = (const float*)d_in[10]; const float* ssd_dt_bias = (const float*)d_in[11];
    const float* ssd_a_log = (const float*)d_in[12]; const float* ssd_d = (const float*)d_in[13]; const float* ssd_norm_w = (const float*)d_in[14]; const float* w_out = (const float*)d_in[15];
    const float* final_norm_w = (const float*)d_in[16];
    char* ws = (char*)d_ws; float* out = (float*)d_out;
    bf16* W1T = (bf16*)(ws + WS_W1T); bf16* W2T = (bf16*)(ws + WS_W2T); float* RSS = (float*)(ws + WS_RSS); float* DECG = (float*)(ws + WS_DECG); float* DECS = (float*)(ws + WS_DECS);
    bf16* XB = (bf16*)(ws + WS_XB); bf16* MIX = (bf16*)(ws + WS_MIX); float* UPD = (float*)(ws + WS_UPD); bf16* ST = (bf16*)(ws + WS_ST); bf16* PROJ = (bf16*)(ws + WS_PROJ);
    k_pro_w1<<<(2 * D * NP + 255) / 256, 256, 0, stream>>>(w_in, norm_w, gate_w, W1T);
    k_pro_w2<<<(2 * D * D + 255) / 256, 256, 0, stream>>>(w_out, W2T);
    k_pro_x<<<T / 4, 256, 0, stream>>>(x, XB, RSS);
    for (int l = 0; l < 2; ++l) {
        k_gemm<1><<<dim3(NP / 64, T / 64), 256, 0, stream>>>(XB, W1T + (size_t)l * NP * D, T, NP, D, RSS, PROJ, nullptr, nullptr, nullptr);
        k_conva<<<T * 256 / 256, 256, 0, stream>>>(PROJ, conv_a_w + l * 3 * 256, MIX);
        k_pool<<<T, 256, 0, stream>>>(PROJ, pool_w + l * 4 * 64 * 64, pool_scale + l * 256, MIX);
        k_gla_local<<<NCHUNK, 256, 0, stream>>>(PROJ, gate_b + l * 128, UPD, DECG);
        k_ssd_local<<<NCHUNK, 256, 0, stream>>>(PROJ, ssd_conv_w + l * 4 * 768, ssd_conv_b + l * 768, ssd_dt_bias + l * 4, ssd_a_log + l * 4, UPD, DECS);
        k_scan<<<NB * NSTATE / 256, 256, 0, stream>>>(UPD, DECG, DECS, ST);
        k_gla_out<<<NCHUNK, 256, 0, stream>>>(PROJ, ST, gla_norm_w + l * 64, MIX);
        k_ssd_out<<<NCHUNK, 256, 0, stream>>>(PROJ, ST, ssd_conv_w + l * 4 * 768, ssd_conv_b + l * 768, ssd_d + l * 4, ssd_norm_w + l * 256, MIX);
        k_gemm<2><<<dim3(D / 64, T / 64), 256, 0, stream>>>(MIX, W2T + (size_t)l * D * D, T, D, D, nullptr, nullptr, l == 0 ? x : out, out, XB);
        k_rss<<<T / 4, 256, 0, stream>>>(out, RSS);
    }
    k_final<<<T / 4, 256, 0, stream>>>(out, final_norm_w);
}
```

```cpp
#include <hip/hip_runtime.h>
#include <cstdio>
#include <cstdint>
namespace pg8 {
#define PG8_LAS __attribute__((address_space(3)))
typedef unsigned short bf16_t;
typedef short bf16x8 __attribute__((ext_vector_type(8)));
typedef float f32x4 __attribute__((ext_vector_type(4)));
typedef unsigned u32x4 __attribute__((ext_vector_type(4)));
constexpr int BM = 256, BK = 64, HALF = 128, HTB = HALF * BK * 2  , STAGE_BYTES = 8 * HTB, NXCD = 8, WGM = 8;

__host__ __device__ __forceinline__ int lds_byte(int r, int c) { const int st = (r >> 4) * 2 + (c >> 5), rr = r & 15, cc = c & 31, ob = rr * 64 + cc * 2; return st * 1024 + (ob ^ (((ob >> 9) & 1) << 5)); }
__host__ __device__ __forceinline__ void stage_rc(int b, int& R, int& C) { const int st = b / 1024, sb = b % 1024, swz = sb ^ (((sb >> 9) & 1) << 5); R = (st >> 1) * 16 + swz / 64; C = (st & 1) * 32 + (swz % 64) / 2; }
__host__ __device__ __forceinline__ int perm32(int rho) { const int n = rho >> 4, i = rho & 15; return 8 * (i >> 2) + 4 * n + (i & 3); }

struct Unit { int pm, pn; };
struct Gemm { const bf16_t* A; const bf16_t* Bt; int M, N, K; };

struct StaticOrder {
    int nM, nN, nwg, G, c;
    __host__ __device__ void init(int M, int N, int G_, int c_) { nM = M / BM; nN = N / BM; nwg = nM * nN; G = G_; c = c_; }
    __host__ __device__ bool next(int i, Unit& u) const {
        const long L = (long)i * G + c; if (L >= nwg) return false;
        int wgid = (int)L; { const int q = nwg / NXCD, r = nwg % NXCD, xcd = wgid % NXCD, off = wgid / NXCD; wgid = (xcd < r ? xcd * (q + 1) : r * (q + 1) + (xcd - r) * q) + off; }
        const int nig = WGM * nN, gid = wgid / nig, fm = gid * WGM, gsz = (nM - fm) < WGM ? (nM - fm) : WGM;
        u.pm = fm + ((wgid % nig) % gsz); u.pn = (wgid % nig) / gsz; return true;
    }
    __device__ __forceinline__ void a_ready(const Unit&) const {}
    __device__ __forceinline__ void done(const Unit&) const {}
};

__device__ __forceinline__ unsigned cvt_pk_bf16(float lo, float hi) { unsigned r; asm volatile("v_cvt_pk_bf16_f32 %0, %1, %2" : "=v"(r) : "v"(lo), "v"(hi)); return r; }
constexpr int EPI_P_OFF = 135168;
struct EpiProj {
    static constexpr bool PERM = true, AFTER_DRAIN = false;
    bf16_t* O; int ldc; const float* rss; float inv_k, eps;
    __device__ __forceinline__ void operator()(const f32x4 (&acc)[2][2][4][2], const Unit& u, int wr, int wc, int fr, int fq, PG8_LAS unsigned char*, int, int) const {
        const int row0 = u.pm * BM + wr * 64 + fr, col0 = u.pn * BM + wc * 32 + 8 * fq;
#pragma unroll
        for (int ai = 0; ai < 2; ++ai)
#pragma unroll
            for (int m = 0; m < 4; ++m) { const int row = row0 + ai * HALF + m * 16; const f32x4 p = *(const f32x4*)(rss + (size_t)row * 4);
                const float rs = __builtin_amdgcn_rsqf(((p[0] + p[1]) + (p[2] + p[3])) * inv_k + eps);
                bf16_t* rowp = O + (size_t)row * ldc + col0;
#pragma unroll
                for (int bj = 0; bj < 2; ++bj) { const f32x4 v0 = acc[ai][bj][m][0] * rs, v1 = acc[ai][bj][m][1] * rs;
                    u32x4 w; w.x = cvt_pk_bf16(v0[0], v0[1]); w.y = cvt_pk_bf16(v0[2], v0[3]); w.z = cvt_pk_bf16(v1[0], v1[1]); w.w = cvt_pk_bf16(v1[2], v1[3]);
                    *(u32x4*)(rowp + bj * HALF) = w; } }
    }
};
struct EpiRes {
    static constexpr bool PERM = false, AFTER_DRAIN = false;
    const float* base; float* out; bf16_t* xb; float* rss; int ldc;
    __device__ __forceinline__ void operator()(const f32x4 (&acc)[2][2][4][2], const Unit& u, int wr, int wc, int fr, int fq, PG8_LAS unsigned char* lds, int wid, int lane) const {
        typedef unsigned u32x2v __attribute__((ext_vector_type(2)));
        PG8_LAS float* P = (PG8_LAS float*)(lds + EPI_P_OFF);
        const int col0 = u.pn * BM + wc * 32 + 4 * fq;
#pragma unroll
        for (int ai = 0; ai < 2; ++ai)
#pragma unroll
            for (int m = 0; m < 4; ++m) { const int r = ai * HALF + wr * 64 + m * 16 + fr; const size_t off = (size_t)(u.pm * BM + r) * ldc + col0; float ss = 0.f;
#pragma unroll
                for (int bj = 0; bj < 2; ++bj)
#pragma unroll
                    for (int n = 0; n < 2; ++n) { const f32x4 bs = *(const f32x4*)(base + off + bj * HALF + n * 16); const f32x4 o = bs + acc[ai][bj][m][n];
                        *(f32x4*)(out + off + bj * HALF + n * 16) = o; ss += (o[0] * o[0] + o[1] * o[1]) + (o[2] * o[2] + o[3] * o[3]);
                        u32x2v w; w.x = cvt_pk_bf16(o[0], o[1]); w.y = cvt_pk_bf16(o[2], o[3]); *(u32x2v*)(xb + off + bj * HALF + n * 16) = w; }
                ss += __shfl_xor(ss, 16); ss += __shfl_xor(ss, 32);
                if (fq == 0) P[r * 4 + wc] = ss;
                if (m & 1) asm volatile("" ::: "memory"); }
        asm volatile("s_waitcnt lgkmcnt(0)" ::: "memory"); __builtin_amdgcn_s_barrier(); asm volatile("" ::: "memory");
        const int tid = wid * 64 + lane;
        if (tid < 256) { const f32x4 p = *(const PG8_LAS f32x4*)(P + tid * 4); rss[(size_t)(u.pm * BM + tid) * 4 + u.pn] = (p[0] + p[1]) + (p[2] + p[3]); }
    }
};
template <class Epi, class Sched, bool ALIGN_EPI = false, bool SP2 = false>
__device__ __forceinline__ void gemm_phase(PG8_LAS unsigned char* lds, const Gemm g, const Sched& S, const Epi& E) {
    const int tid = threadIdx.x, wid = __builtin_amdgcn_readfirstlane(tid >> 6), lane = tid & 63, wr = wid >> 2, wc = wid & 3, fr = lane & 15, fq = lane >> 4;
    const int K = g.K, nt = K / BK;
    unsigned voffA[2], voffB[2];
#pragma unroll
    for (int i = 0; i < 2; ++i) { int R, C; stage_rc(tid * 16 + i * 8192, R, C); const int Rb = Epi::PERM ? ((R & ~31) + perm32(R & 31)) : R;
        voffA[i] = (unsigned)(R * K + C) * 2u; voffB[i] = (unsigned)(Rb * K + C) * 2u; }
    const size_t kstep = (size_t)(BK * 2);
    const size_t hstep = (size_t)HALF * K * 2;
    const size_t tstep = 2 * hstep;
    const unsigned ldsw = (unsigned)wid * 1024u;
    const int aoff = lds_byte(wr * 64 + fr, fq * 8), boff = lds_byte(wc * 32 + fr, fq * 8);
#define PG8_SA(b, h) (((b) * 2 + (h)) * HTB)
#define PG8_SB(b, h) ((4 + (b) * 2 + (h)) * HTB)
#define PG8_STAGE(bufoff, gbase, voff) do { _Pragma("unroll") for (int _i = 0; _i < 2; ++_i) \
        __builtin_amdgcn_global_load_lds((const unsigned*)((const char*)(gbase) + (voff)[_i]), (PG8_LAS unsigned*)(lds + (bufoff) + ldsw + _i * 8192), 16, 0, 0); } while (0)
#define PG8_LDA(dst, b, h) do { _Pragma("unroll") for (int m = 0; m < 4; ++m) _Pragma("unroll") for (int k = 0; k < 2; ++k) dst[m][k] = *(const PG8_LAS bf16x8*)(lds + PG8_SA(b, h) + aoff + m * 2048 + k * 1024); } while (0)
#define PG8_LDB(dst, b, h) do { _Pragma("unroll") for (int n = 0; n < 2; ++n) _Pragma("unroll") for (int k = 0; k < 2; ++k) dst[n][k] = *(const PG8_LAS bf16x8*)(lds + PG8_SB(b, h) + boff + n * 2048 + k * 1024); } while (0)
#define PG8_MMA(ai, bj, At, Bt) do { __builtin_amdgcn_s_setprio(1); _Pragma("unroll") for (int m = 0; m < 4; ++m) _Pragma("unroll") for (int n = 0; n < 2; ++n) _Pragma("unroll") for (int k = 0; k < 2; ++k) \
        acc[ai][bj][m][n] = __builtin_amdgcn_mfma_f32_16x16x32_bf16(Bt[n][k], At[m][k], acc[ai][bj][m][n], 0, 0, 0); __builtin_amdgcn_s_setprio(0); } while (0)
#define PG8_WAIT_V(n) asm volatile("s_waitcnt vmcnt(" #n ")" ::: "memory")
#define PG8_WAIT_L(n) asm volatile("s_waitcnt lgkmcnt(" #n ")" ::: "memory")
#define PG8_BAR __builtin_amdgcn_s_barrier()
#define PG8_SCHED __builtin_amdgcn_sched_barrier(0)
    Unit cur, nxt; int ui = 0;
    if (!S.next(0, cur)) return;
    f32x4 acc[2][2][4][2];
#pragma unroll
    for (int a = 0; a < 2; ++a)
#pragma unroll
        for (int b = 0; b < 2; ++b)
#pragma unroll
            for (int m = 0; m < 4; ++m)
#pragma unroll
                for (int n = 0; n < 2; ++n) acc[a][b][m][n] = (f32x4){0.f, 0.f, 0.f, 0.f};
    bf16x8 At[4][2], B0[2][2], B1[2][2];
    const char* cA = (const char*)g.A + (size_t)cur.pm * tstep; const char* cB = (const char*)g.Bt + (size_t)cur.pn * tstep;
    S.a_ready(cur);
    if constexpr (SP2) {
        PG8_STAGE(PG8_SB(0, 0), cB, voffB); PG8_STAGE(PG8_SB(0, 1), cB + hstep, voffB); PG8_STAGE(PG8_SA(0, 0), cA, voffA); PG8_STAGE(PG8_SA(0, 1), cA + hstep, voffA);
        if (wr == 1) PG8_BAR;
        PG8_WAIT_V(2); PG8_BAR;
        PG8_STAGE(PG8_SB(1, 0), cB + kstep, voffB); PG8_STAGE(PG8_SA(1, 0), cA + kstep, voffA); PG8_STAGE(PG8_SB(1, 1), cB + hstep + kstep, voffB);
        PG8_WAIT_V(6); PG8_BAR;
    } else {
        PG8_STAGE(PG8_SB(0, 0), cB, voffB); PG8_STAGE(PG8_SA(0, 0), cA, voffA); PG8_STAGE(PG8_SB(0, 1), cB + hstep, voffB); PG8_STAGE(PG8_SA(0, 1), cA + hstep, voffA);
        if (wr == 1) PG8_BAR;
        PG8_WAIT_V(4); PG8_BAR;
        PG8_STAGE(PG8_SB(1, 0), cB + kstep, voffB); PG8_STAGE(PG8_SA(1, 0), cA + kstep, voffA); PG8_STAGE(PG8_SB(1, 1), cB + hstep + kstep, voffB);
        PG8_WAIT_V(6); PG8_BAR;
    }
    for (;;) {
        const bool has_next = S.next(ui + 1, nxt);
        const char* nA = has_next ? (const char*)g.A + (size_t)nxt.pm * tstep : cA; const char* nB = has_next ? (const char*)g.Bt + (size_t)nxt.pn * tstep : cB;
        for (int t = 0; t < nt; t += 2) {
            const bool last = (t == nt - 2);
            const char* a1 = cA + (size_t)(t + 1) * kstep;
            const char* a2 = last ? nA : cA + (size_t)(t + 2) * kstep; const char* b2 = last ? nB : cB + (size_t)(t + 2) * kstep;
            const char* a3 = a2 + kstep; const char* b3 = b2 + kstep;
            if (last && has_next) S.a_ready(nxt);
            if constexpr (SP2) {
            PG8_LDB(B0, 0, 0); PG8_LDB(B1, 0, 1); PG8_SCHED; PG8_LDA(At, 0, 0); PG8_STAGE(PG8_SA(1, 1), a1 + hstep, voffA);
            PG8_WAIT_V(8); PG8_WAIT_L(0); PG8_BAR; PG8_MMA(0, 0, At, B0); PG8_MMA(0, 1, At, B1); PG8_BAR; PG8_SCHED;
            PG8_LDA(At, 0, 1); PG8_STAGE(PG8_SB(0, 0), b2, voffB); PG8_STAGE(PG8_SB(0, 1), b2 + hstep, voffB); PG8_STAGE(PG8_SA(0, 0), a2, voffA);
            PG8_WAIT_V(8); PG8_WAIT_L(0); PG8_BAR; PG8_MMA(1, 0, At, B0); PG8_MMA(1, 1, At, B1); PG8_BAR; PG8_SCHED;
            PG8_LDB(B0, 1, 0); PG8_LDB(B1, 1, 1); PG8_SCHED; PG8_LDA(At, 1, 0); PG8_STAGE(PG8_SA(0, 1), a2 + hstep, voffA);
            PG8_WAIT_V(8); PG8_WAIT_L(0); PG8_BAR; PG8_MMA(0, 0, At, B0); PG8_MMA(0, 1, At, B1); PG8_BAR; PG8_SCHED;
            PG8_LDA(At, 1, 1); PG8_STAGE(PG8_SB(1, 0), b3, voffB); PG8_STAGE(PG8_SB(1, 1), b3 + hstep, voffB); PG8_STAGE(PG8_SA(1, 0), a3, voffA);
            PG8_WAIT_V(8); PG8_WAIT_L(0); PG8_BAR; PG8_MMA(1, 0, At, B0); PG8_MMA(1, 1, At, B1); PG8_BAR; PG8_SCHED;
            } else {
            PG8_LDB(B0, 0, 0); PG8_SCHED; PG8_LDA(At, 0, 0); PG8_STAGE(PG8_SA(1, 1), a1 + hstep, voffA);
            PG8_WAIT_L(8); PG8_BAR; PG8_WAIT_L(0); PG8_MMA(0, 0, At, B0); PG8_BAR; PG8_SCHED;
            PG8_LDB(B1, 0, 1); PG8_STAGE(PG8_SB(0, 0), b2, voffB);
            PG8_BAR; PG8_WAIT_L(0); PG8_MMA(0, 1, At, B1); PG8_BAR;
            PG8_LDA(At, 0, 1); PG8_STAGE(PG8_SA(0, 0), a2, voffA);
            PG8_BAR; PG8_WAIT_L(0); PG8_MMA(1, 0, At, B0); PG8_BAR; PG8_SCHED;
            PG8_STAGE(PG8_SB(0, 1), b2 + hstep, voffB);
            PG8_WAIT_V(6); PG8_BAR; PG8_MMA(1, 1, At, B1); PG8_BAR;
            PG8_LDB(B0, 1, 0); PG8_SCHED; PG8_LDA(At, 1, 0); PG8_STAGE(PG8_SA(0, 1), a2 + hstep, voffA);
            PG8_WAIT_L(8); PG8_BAR; PG8_WAIT_L(0); PG8_MMA(0, 0, At, B0); PG8_BAR; PG8_SCHED;
            PG8_LDB(B1, 1, 1); PG8_STAGE(PG8_SB(1, 0), b3, voffB);
            PG8_BAR; PG8_WAIT_L(0); PG8_MMA(0, 1, At, B1); PG8_BAR;
            PG8_LDA(At, 1, 1); PG8_STAGE(PG8_SA(1, 0), a3, voffA);
            PG8_BAR; PG8_WAIT_L(0); PG8_MMA(1, 0, At, B0); PG8_BAR; PG8_SCHED;
            PG8_STAGE(PG8_SB(1, 1), b3 + hstep, voffB);
            PG8_WAIT_V(6); PG8_BAR; PG8_MMA(1, 1, At, B1); PG8_BAR;
            }
        }
        if constexpr (ALIGN_EPI) { if (wr == 0) PG8_BAR; }
        if constexpr (!Epi::AFTER_DRAIN) { E(acc, cur, wr, wc, fr, fq, lds, wid, lane); S.done(cur); }
        if (!has_next) break;
#pragma unroll
        for (int a = 0; a < 2; ++a)
#pragma unroll
            for (int b = 0; b < 2; ++b)
#pragma unroll
                for (int m = 0; m < 4; ++m)
#pragma unroll
                    for (int n = 0; n < 2; ++n) acc[a][b][m][n] = (f32x4){0.f, 0.f, 0.f, 0.f};
        cur = nxt; cA = nA; cB = nB; ++ui;
        if constexpr (ALIGN_EPI) { if (wr == 1) PG8_BAR; }
    }
    PG8_WAIT_V(0);
    if constexpr (!ALIGN_EPI) { if (wr == 0) PG8_BAR; }
    PG8_BAR;
    if constexpr (Epi::AFTER_DRAIN) { E.fused(acc, cur, wr, wc, fr, fq, lds, wid, lane); S.done(cur); }
#undef PG8_SA
#undef PG8_SB
#undef PG8_STAGE
#undef PG8_LDA
#undef PG8_LDB
#undef PG8_MMA
#undef PG8_WAIT_V
#undef PG8_WAIT_L
#undef PG8_BAR
#undef PG8_SCHED
}
}
constexpr int NWAVES = 8, NTHR = NWAVES * 64;
constexpr int T = 32768, D = 1024, SEQ = 8192, NB = 4, CH = 64, NCHUNK = 512, NCB = 128, DEPTH = 2;
constexpr int NP = 3584;
constexpr int DPROJ = 3348;
constexpr float EPS = 1e-6f;
constexpr int C_AH = 0, C_AB = 256, C_AC = 512, C_AZ = 768, C_Q = 1024, C_K = 1152, C_V = 1280, C_GZ = 1536,
              C_PU = 1792, C_PZ = 2048, C_SZ = 2304, C_XS = 2560, C_BM = 2816, C_CM = 3072, C_GATE = 3328, C_DT = 3456;
constexpr int NSTATE = 40960;
constexpr size_t MiB = 1u << 20;
constexpr size_t WS_CTL = 0, CTL_ZERO_BYTES = 1 * MiB;
constexpr size_t WS_W1T = 1 * MiB, WS_W2T = 15 * MiB, WS_PWT = 19 * MiB, WS_RSS = 20 * MiB, WS_DECG = 21 * MiB, WS_DECS = 21 * MiB + 512 * 1024,
                 WS_XB = 32 * MiB, WS_MIX = 96 * MiB, WS_UPD = 160 * MiB, WS_ST = 240 * MiB, WS_PROJ = 280 * MiB, WS_END = 504 * MiB;
constexpr int CW_BAR = 4096;
constexpr int RING_OFF = 0, RING_BYTES = 131072;
constexpr int LDSCTL_OFF = RING_BYTES, MISC_OFF = LDSCTL_OFF + 320;
constexpr int LDS_BYTES = 147456;
static_assert(pg8::EPI_P_OFF >= MISC_OFF + 128 && pg8::EPI_P_OFF + 4096 <= LDS_BYTES, "LDS map");
#define GAS __attribute__((address_space(1)))
#define LAS __attribute__((address_space(3)))
typedef unsigned short bf16;
typedef unsigned v4u __attribute__((ext_vector_type(4)));
typedef float f32x4 __attribute__((ext_vector_type(4)));
typedef short bf16x8 __attribute__((ext_vector_type(8)));
typedef GAS unsigned gu32;
typedef GAS unsigned long long gu64;
#define RLX_AGENT __ATOMIC_RELAXED, __HIP_MEMORY_SCOPE_AGENT
#define LDS_WAIT() asm volatile("s_waitcnt lgkmcnt(0)" ::: "memory")
#define VM_WAIT() asm volatile("s_waitcnt vmcnt(0)" ::: "memory")
__device__ __forceinline__ unsigned long long rt() { return __builtin_amdgcn_s_memrealtime(); }
__device__ __forceinline__ unsigned f2bf(float f) { unsigned u = __builtin_bit_cast(unsigned, f); return (u + 0x7fffu + ((u >> 16) & 1u)) >> 16; }
__device__ __forceinline__ unsigned pk2(float lo, float hi) { return f2bf(lo) | (f2bf(hi) << 16); }

#define XB_TMO      128
#define XB_XCNT(j)  (256  + 64 * (j))
#define XB_XSUB(j)  (1280 + 64 * (j))
#define XB_XGEN(j)  (2304 + 64 * (j))
#define XB_TOP      3328
#define XB_TOPGEN   3392
#define XCD_BAR_WORDS 3456
#define XB_SPIN_CAP (1u << 18)

__device__ __forceinline__ unsigned xb_ld(unsigned* p)              { return __hip_atomic_load(p, __ATOMIC_RELAXED, __HIP_MEMORY_SCOPE_AGENT); }
__device__ __forceinline__ unsigned xb_add(unsigned* p, unsigned v) { return __hip_atomic_fetch_add(p, v, __ATOMIC_RELAXED, __HIP_MEMORY_SCOPE_AGENT); }
__device__ __forceinline__ unsigned xb_xcc_id() { return (unsigned)__builtin_amdgcn_s_getreg((3 << 11) | 20) & 0xFu; }
#define XB_SPIN(cond, bar) do { unsigned _sp = 0; while (cond) { __builtin_amdgcn_s_sleep(1); \
    if ((++_sp & 255u) == 0u) { if (xb_ld(&(bar)[XB_TMO])) break; if (_sp > XB_SPIN_CAP) { atomicAdd(&(bar)[XB_TMO], 1u); break; } } } } while (0)

struct XcdBarrier {
    unsigned* bar; unsigned x;
    volatile LAS unsigned* st;
};

__device__ __forceinline__ XcdBarrier xcd_barrier_post(unsigned* bar, volatile LAS unsigned* st) {
    XcdBarrier b; b.bar = bar; b.x = xb_xcc_id(); b.st = st;
    if (threadIdx.x == 0) (void)xb_add(&bar[XB_XCNT(b.x)], 1u);
    return b;
}
__device__ __forceinline__ void xcd_barrier_complete(unsigned* bar, unsigned x, unsigned& nloc, unsigned& nx) {
    const unsigned G = gridDim.x * gridDim.y * gridDim.z;
    unsigned sum, cnt, mine, sp = 0u;
    for (;;) {
        sum = 0u; cnt = 0u; mine = 0u;
#pragma unroll
        for (unsigned j = 0; j < 16; ++j) { const unsigned c = xb_ld(&bar[XB_XCNT(j)]); sum += c; cnt += (c > 0u) ? 1u : 0u; mine = (j == x) ? c : mine; }
        if (sum == G) break;
        __builtin_amdgcn_s_sleep(1);
        if ((++sp & 255u) == 0u) { if (xb_ld(&bar[XB_TMO])) break; if (sp > XB_SPIN_CAP) { atomicAdd(&bar[XB_TMO], 1u); break; } }
    }
    nloc = mine > 0u ? mine : 1u; nx = cnt > 0u ? cnt : 1u;
}

__device__ __forceinline__ void xcd_barrier(const XcdBarrier& b) {
    asm volatile("s_waitcnt vmcnt(0)" ::: "memory");
    __syncthreads();
    if (threadIdx.x == 0) {
        unsigned* bar = b.bar;
        __builtin_amdgcn_s_waitcnt(0);
        unsigned nloc = b.st[0], nx = b.st[1];
        if (nloc == 0u) { xcd_barrier_complete(bar, b.x, nloc, nx); b.st[0] = nloc; b.st[1] = nx; }
        const unsigned old = xb_add(&bar[XB_XSUB(b.x)], 1u);
        const unsigned gen = old / nloc;
        if (old + 1u == (gen + 1u) * nloc) {
            __builtin_amdgcn_fence(__ATOMIC_RELEASE, "agent");
            asm volatile("s_waitcnt vmcnt(0)" ::: "memory");
            const unsigned og = xb_add(&bar[XB_TOP], 1u);
            const unsigned tg = og / nx;
            if (og + 1u == (tg + 1u) * nx) xb_add(&bar[XB_TOPGEN], 1u);
            else XB_SPIN(xb_ld(&bar[XB_TOPGEN]) == tg, bar);
            __builtin_amdgcn_fence(__ATOMIC_ACQUIRE, "agent");
            xb_add(&bar[XB_XGEN(b.x)], 1u);
            asm volatile("s_waitcnt vmcnt(0)" ::: "memory");
        } else {
            XB_SPIN(xb_ld(&bar[XB_XGEN(b.x)]) == gen, bar);
            __builtin_amdgcn_fence(__ATOMIC_ACQUIRE, "agent");
            asm volatile("s_waitcnt vmcnt(0)" ::: "memory");
        }
    }
    __syncthreads();
}
struct Args { const float* in[17]; float* out; unsigned char* ws; int ph_lo, ph_hi, li, pad; };
enum { I_X = 0, I_NORM_W, I_W_IN, I_CONV_A_W, I_GATE_W, I_GATE_B, I_GLA_NORM_W, I_POOL_W, I_POOL_SCALE, I_SSD_CONV_W, I_SSD_CONV_B, I_SSD_DT_BIAS, I_SSD_A_LOG, I_SSD_D, I_SSD_NORM_W, I_W_OUT, I_FINAL_NORM_W };
typedef const __attribute__((address_space(4))) struct Args* ArgsPfwd;
struct Frame {
    LAS unsigned char* lds;
    volatile LAS unsigned* MISC;
    gu32* ctl;
    ArgsPfwd ap;
    int tid, lane, wave;
    int vcu, G;
};
typedef const __attribute__((address_space(4))) Args* ArgsP;
#define PHASE_ARGS() ArgsP ap = F.ap; asm volatile("" : "+s"(ap))
#define PHASE_BEGIN() Frame F = F0; asm volatile("" : "+v"(F.tid), "+v"(F.lane)); PHASE_ARGS()
#define FIN(i) (ap->in[i])
#define FWS(T_, off) ((T_*)(ap->ws + (off)))
__device__ __forceinline__ float bf2f(unsigned v) { return __uint_as_float(v << 16); }
__device__ __forceinline__ float silu_f(float x) { return x / (1.f + __expf(-x)); }
__device__ __forceinline__ float softplus_f(float x) { return fmaxf(x, 0.f) + log1pf(__expf(-fabsf(x))); }
__device__ __forceinline__ float logsigmoid_f(float x) { return fminf(x, 0.f) - log1pf(__expf(-fabsf(x))); }
__device__ __forceinline__ float wave_sum(float v) {
#pragma unroll
    for (int o = 1; o < 64; o <<= 1) v += __shfl_xor(v, o);
    return v;
}
__device__ __forceinline__ void p0_item(Frame& F, int kind, int l, int kb, int nb, LAS float* scr) {
    PHASE_ARGS();
    const int lane = F.lane, k0 = 64 * kb, n0 = 32 * nb, n = lane & 31, nn = n0 + n;
    if (kind == 0) {
        const float* W = FIN(I_W_IN) + (size_t)l * D * DPROJ; const float* gw = FIN(I_GATE_W) + (size_t)l * 16 * 128; const float* nw = FIN(I_NORM_W) + l * D;
#pragma unroll 4
        for (int i = 0; i < 32; ++i) { const int kk = 2 * i + (lane >> 5), k = k0 + kk; const float* Wr = W + (size_t)k * DPROJ; float v;
            if (nn < 1536) v = Wr[nn];
            else if (nn < 3328) v = Wr[nn + 16];
            else if (nn < 3456) { float s = 0.f;
#pragma unroll
                for (int r = 0; r < 16; ++r) s += Wr[1536 + r] * gw[r * 128 + (nn - 3328)];
                v = s; }
            else if (nn < 3460) v = Wr[3344 + (nn - 3456)];
            else v = 0.f;
            scr[kk * 33 + n] = v * nw[k]; }
    } else {
        const float* W = FIN(I_W_OUT) + (size_t)l * D * D;
#pragma unroll 8
        for (int i = 0; i < 32; ++i) { const int kk = 2 * i + (lane >> 5); scr[kk * 33 + n] = W[(size_t)(k0 + kk) * D + nn]; }
    }
    LDS_WAIT(); asm volatile("" ::: "memory");
    bf16* WT = kind == 0 ? FWS(bf16, WS_W1T) + (size_t)l * NP * D : FWS(bf16, WS_W2T) + (size_t)l * D * D;
    const int c = lane & 7;
#pragma unroll
    for (int j = 0; j < 4; ++j) { const int n2 = (lane >> 3) + 8 * j; const LAS float* s = scr + (8 * c) * 33 + n2;
        v4u o; o.x = pk2(s[0 * 33], s[1 * 33]); o.y = pk2(s[2 * 33], s[3 * 33]); o.z = pk2(s[4 * 33], s[5 * 33]); o.w = pk2(s[6 * 33], s[7 * 33]);
        *(GAS v4u*)(WT + (size_t)(n0 + n2) * D + k0 + 8 * c) = o; }
    LDS_WAIT(); asm volatile("" ::: "memory");
}
__device__ __forceinline__ void p0_prologue(const Frame& F0) {
    PHASE_BEGIN();
    LAS float* scr = (LAS float*)(F.lds + RING_OFF + F.wave * 16384);
    const int gw = F.vcu * NWAVES + F.wave, NGW = F.G * NWAVES;
    constexpr int I_W1 = (D / 64) * (NP / 32), I_W2 = (D / 64) * (D / 32), I_L = I_W1 + I_W2;
    for (int it = gw; it < DEPTH * I_L; it += NGW) {
        const int l = it / I_L; int r = it % I_L;
        if (r < I_W1) p0_item(F, 0, l, r / (NP / 32), r % (NP / 32), scr);
        else { r -= I_W1; p0_item(F, 1, l, r / (D / 32), r % (D / 32), scr); }
    }
    for (int i = (blockIdx.x * NTHR + F.tid); i < DEPTH * 4 * 64 * 64; i += F.G * NTHR) { const int c = i & 63, d = (i >> 6) & 63, lg = i >> 12; FWS(bf16, WS_PWT)[i] = (bf16)f2bf(FIN(I_POOL_W)[(size_t)lg * 4096 + c * 64 + d]); }
    for (int m = gw; m < T; m += NGW) {
        const GAS f32x4* xr = (const GAS f32x4*)(FIN(I_X) + (size_t)m * D) + F.lane; f32x4 v[4]; float s = 0.f;
#pragma unroll
        for (int j = 0; j < 4; ++j) { v[j] = xr[64 * j]; s += (v[j].x * v[j].x + v[j].y * v[j].y) + (v[j].z * v[j].z + v[j].w * v[j].w); }
        s = wave_sum(s);
        GAS unsigned long long* o8 = (GAS unsigned long long*)(FWS(bf16, WS_XB) + (size_t)m * D) + F.lane;
#pragma unroll
        for (int j = 0; j < 4; ++j) o8[64 * j] = (unsigned long long)pk2(v[j].x, v[j].y) | ((unsigned long long)pk2(v[j].z, v[j].w) << 32);
        if (F.lane == 0) *(GAS f32x4*)(FWS(float, WS_RSS) + (size_t)m * 4) = (f32x4){s, 0.f, 0.f, 0.f};
    }
}
__device__ __forceinline__ void fn_final(const Frame& F0) {
    PHASE_BEGIN();
    const int gw = F.vcu * NWAVES + F.wave, NGW = F.G * NWAVES;
    f32x4 w[4];
#pragma unroll
    for (int j = 0; j < 4; ++j) w[j] = ((const GAS f32x4*)FIN(I_FINAL_NORM_W))[F.lane + 64 * j];
    for (int m = gw; m < T; m += NGW) {
        GAS f32x4* xr = (GAS f32x4*)(ap->out + (size_t)m * D) + F.lane; f32x4 v[4]; float s = 0.f;
#pragma unroll
        for (int j = 0; j < 4; ++j) { v[j] = xr[64 * j]; s += (v[j].x * v[j].x + v[j].y * v[j].y) + (v[j].z * v[j].z + v[j].w * v[j].w); }
        const float rstd = rsqrtf(wave_sum(s) * (1.f / D) + EPS);
#pragma unroll
        for (int j = 0; j < 4; ++j) xr[64 * j] = v[j] * rstd * w[j];
    }
}
__device__ __forceinline__ float xbc_act(const bf16* PROJ, const float* cw  , const float* cb, int t, int pos, int j) {
    float a = cb[j];
#pragma unroll
    for (int k = 0; k < 4; ++k) { const int d = 3 - k; if (pos - d >= 0) a += cw[k * 768 + j] * bf2f(PROJ[(size_t)(t - d) * NP + C_XS + j]); }
    return silu_f(a);
}
__device__ __forceinline__ void m1_naive(const Frame& F0, int l) {
    PHASE_BEGIN();
    const int tid = F.tid; const bf16* PROJ = FWS(bf16, WS_PROJ); bf16* MIX = FWS(bf16, WS_MIX);
    { const float* cw = FIN(I_CONV_A_W) + l * 3 * 256;
      for (size_t idx = (size_t)blockIdx.x * NTHR + tid; idx < (size_t)T * 256; idx += (size_t)F.G * NTHR) {
        const int ch = idx & 255; const int t = (int)(idx >> 8); const int pos = t & (SEQ - 1); float acc = 0.f;
#pragma unroll
        for (int k = 0; k < 3; ++k) { const int d = 2 - k; if (pos - d >= 0) { const bf16* r = PROJ + (size_t)(t - d) * NP; acc += cw[k * 256 + ch] * (bf2f(r[C_AC + ch]) * bf2f(r[C_AH + ch])); } }
        const bf16* r = PROJ + (size_t)t * NP;
        MIX[(size_t)t * D + ch] = (bf16)f2bf(bf2f(r[C_AB + ch]) * acc * silu_f(bf2f(r[C_AZ + ch]))); } }
    { LAS float* pooled = (LAS float*)F.lds; const float* pw = FIN(I_POOL_W) + l * 4 * 64 * 64; const float* pscale = FIN(I_POOL_SCALE) + l * 256;
      for (int vb = blockIdx.x; vb < T / 2; vb += F.G) {
        const int t = 2 * vb + (tid >> 8), pos = t & (SEQ - 1), ch = tid & 255, g = ch >> 6, win = 2 << g; float s = 0.f; int cnt = 0;
        for (int d = 0; d < win; ++d) if (pos - d >= 0) { s += bf2f(PROJ[(size_t)(t - d) * NP + C_PU + ch]); ++cnt; }
        pooled[tid] = s / (float)cnt - bf2f(PROJ[(size_t)t * NP + C_PU + ch]);
        __syncthreads();
        const int dd = ch & 63; float m = 0.f;
        for (int c = 0; c < 64; ++c) m += pooled[(tid & 256) + g * 64 + c] * pw[(g * 64 + c) * 64 + dd];
        MIX[(size_t)t * D + 512 + ch] = (bf16)f2bf(pscale[ch] * m * silu_f(bf2f(PROJ[(size_t)t * NP + C_PZ + ch])));
        __syncthreads(); } }
    LAS float* la = (LAS float*)F.lds;
    LAS float* tot = (LAS float*)(F.lds + 32768);
    LAS float* w = (LAS float*)(F.lds + 33280);
    LAS float* xsw = (LAS float*)(F.lds + 34816);
    LAS float* bm = (LAS float*)(F.lds + 51200);
    const float* gate_b = FIN(I_GATE_B) + l * 128; const float* cw = FIN(I_SSD_CONV_W) + l * 4 * 768; const float* cb = FIN(I_SSD_CONV_B) + l * 768;
    for (int chunk = blockIdx.x; chunk < NCHUNK; chunk += F.G) {
        const int t0 = chunk * CH;
        for (int i = tid; i < 64 * 128; i += NTHR) { const int c = i >> 7, j = i & 127; la[i] = logsigmoid_f(bf2f(PROJ[(size_t)(t0 + c) * NP + C_GATE + j]) + gate_b[j]) * (1.f / 16.f); }
        __syncthreads();
        if (tid < 128) { float s = 0.f; for (int c = 0; c < 64; ++c) { s += la[c * 128 + tid]; la[c * 128 + tid] = s; } tot[tid] = s; FWS(float, WS_DECG)[chunk * 128 + tid] = __expf(s); }
        __syncthreads();
        for (int i = tid; i < 64 * 128; i += NTHR) { const int c = i >> 7, j = i & 127; la[i] = bf2f(PROJ[(size_t)(t0 + c) * NP + C_K + j]) * __expf(tot[j] - la[i]); }
        __syncthreads();
        for (int o = tid; o < 8192; o += NTHR) { const int h = o >> 11, vv = (o >> 5) & 63, kk = o & 31; float s = 0.f;
            for (int c = 0; c < 64; ++c) s += la[c * 128 + h * 32 + kk] * bf2f(PROJ[(size_t)(t0 + c) * NP + C_V + h * 64 + vv]);
            FWS(float, WS_UPD)[(size_t)chunk * NSTATE + o] = s; }
        __syncthreads();
        if (tid < 4) { const int h = tid; const float a = -__expf(FIN(I_SSD_A_LOG)[l * 4 + h]); float s = 0.f;
            for (int c = 0; c < 64; ++c) { const float dt = softplus_f(bf2f(PROJ[(size_t)(t0 + c) * NP + C_DT + h]) + FIN(I_SSD_DT_BIAS)[l * 4 + h]); s += dt * a; w[c * 4 + h] = dt; xsw[c * 64 + h] = s; }
            for (int c = 0; c < 64; ++c) w[c * 4 + h] = __expf(s - xsw[c * 64 + h]) * w[c * 4 + h];
            FWS(float, WS_DECS)[chunk * 4 + h] = __expf(s); }
        __syncthreads();
        for (int h = 0; h < 4; ++h) { const int g = h >> 1;
            __syncthreads();
            for (int i = tid; i < 64 * 64; i += NTHR) { const int c = i >> 6, p = i & 63; const int t = t0 + c; xsw[i] = xbc_act(PROJ, cw, cb, t, t & (SEQ - 1), h * 64 + p) * w[c * 4 + h]; }
            if ((h & 1) == 0) for (int i = tid; i < 64 * 128; i += NTHR) { const int c = i >> 7, s = i & 127; const int t = t0 + c; bm[i] = xbc_act(PROJ, cw, cb, t, t & (SEQ - 1), 256 + g * 128 + s); }
            __syncthreads();
            for (int o = tid; o < 8192; o += NTHR) { const int p = o >> 7, s = o & 127; float acc = 0.f;
                for (int c = 0; c < 64; ++c) acc += xsw[c * 64 + p] * bm[c * 128 + s];
                FWS(float, WS_UPD)[(size_t)chunk * NSTATE + 8192 + h * 8192 + o] = acc; } }
        __syncthreads();
    }
}
__device__ __forceinline__ void m2_naive(const Frame& F0) {
    PHASE_BEGIN();
    for (int idx = blockIdx.x * NTHR + F.tid; idx < NB * NSTATE; idx += F.G * NTHR) {
        const int b = idx / NSTATE, e = idx % NSTATE; float s = 0.f;
        for (int c = 0; c < NCB; ++c) { const int chunk = b * NCB + c;
            const float dec = e < 8192 ? FWS(float, WS_DECG)[chunk * 128 + (e >> 11) * 32 + (e & 31)] : FWS(float, WS_DECS)[chunk * 4 + ((e - 8192) >> 13)];
            s = dec * s + FWS(float, WS_UPD)[(size_t)chunk * NSTATE + e];
            FWS(bf16, WS_ST)[(size_t)chunk * NSTATE + e] = (bf16)f2bf(s); } }
}
__device__ __forceinline__ void m3_naive(const Frame& F0, int l) {
    PHASE_BEGIN();
    const int tid = F.tid; const bf16* PROJ = FWS(bf16, WS_PROJ); bf16* MIX = FWS(bf16, WS_MIX);
    LAS float* cm = (LAS float*)F.lds;
    LAS float* red = (LAS float*)(F.lds + 33280);
    const float* cw = FIN(I_SSD_CONV_W) + l * 4 * 768; const float* cb = FIN(I_SSD_CONV_B) + l * 768;
    for (int chunk = blockIdx.x; chunk < NCHUNK; chunk += F.G) {
        const int c = (tid >> 2) & 63, h = tid & 3, t = chunk * CH + c, g = h >> 1;
        if (tid < 256) {
            float q[32];
#pragma unroll
            for (int kk = 0; kk < 32; ++kk) q[kk] = bf2f(PROJ[(size_t)t * NP + C_Q + h * 32 + kk]) * 0.17677669529663687f;
            const bf16* S = FWS(bf16, WS_ST) + (size_t)chunk * NSTATE + h * 2048; float ss = 0.f;
            for (int vv = 0; vv < 64; ++vv) { float o = 0.f;
#pragma unroll
                for (int kk = 0; kk < 32; ++kk) o += q[kk] * bf2f(S[vv * 32 + kk]);
                ss += o * o; }
            const float rstd = rsqrtf(ss * (1.f / 64.f) + EPS);
            for (int vv = 0; vv < 64; ++vv) { float o = 0.f;
#pragma unroll
                for (int kk = 0; kk < 32; ++kk) o += q[kk] * bf2f(S[vv * 32 + kk]);
                MIX[(size_t)t * D + 256 + h * 64 + vv] = (bf16)f2bf(o * rstd * FIN(I_GLA_NORM_W)[l * 64 + vv] * silu_f(bf2f(PROJ[(size_t)t * NP + C_GZ + h * 64 + vv]))); }
        }
        float ssum = 0.f;
        for (int pass = 0; pass < 2; ++pass) {
            float rstd = 0.f;
            if (pass == 1) rstd = rsqrtf((red[c * 4 + 0] + red[c * 4 + 1] + red[c * 4 + 2] + red[c * 4 + 3]) * (1.f / 256.f) + EPS);
            for (int gg = 0; gg < 2; ++gg) {
                __syncthreads();
                for (int i = tid; i < 64 * 128; i += NTHR) { const int cc = i >> 7, s = i & 127; const int tt = chunk * CH + cc; cm[cc * 129 + s] = xbc_act(PROJ, cw, cb, tt, tt & (SEQ - 1), 512 + gg * 128 + s); }
                __syncthreads();
                if (tid < 256 && g == gg) {
                    const bf16* S = FWS(bf16, WS_ST) + (size_t)chunk * NSTATE + 8192 + h * 8192;
                    for (int p = 0; p < 64; ++p) { float y = 0.f;
                        for (int s = 0; s < 128; ++s) y += cm[c * 129 + s] * bf2f(S[p * 128 + s]);
                        y += FIN(I_SSD_D)[l * 4 + h] * xbc_act(PROJ, cw, cb, t, t & (SEQ - 1), h * 64 + p);
                        y *= silu_f(bf2f(PROJ[(size_t)t * NP + C_SZ + h * 64 + p]));
                        if (pass == 0) ssum += y * y; else MIX[(size_t)t * D + 768 + h * 64 + p] = (bf16)f2bf(y * rstd * FIN(I_SSD_NORM_W)[l * 256 + h * 64 + p]); } }
            }
            if (pass == 0 && tid < 256) red[c * 4 + h] = ssum;
            __syncthreads();
        }
    }
}
constexpr int N_PHASES = 12;
__global__ void __launch_bounds__(NTHR, 2) mk_fwd(Args args) {
    extern __shared__ __attribute__((aligned(16))) unsigned char lds[];
    Frame F;
    F.lds = (LAS unsigned char*)lds;
    F.MISC = (volatile LAS unsigned*)(F.lds + MISC_OFF);
    F.tid = threadIdx.x; F.lane = F.tid & 63; F.wave = __builtin_amdgcn_readfirstlane(F.tid >> 6);
    F.G = gridDim.x; { const int bx = blockIdx.x; F.vcu = (F.G % 8 == 0) ? (bx % 8) * (F.G / 8) + bx / 8 : bx; }
    F.ap = (const __attribute__((address_space(4))) Args*)__builtin_amdgcn_kernarg_segment_ptr();
    { PHASE_ARGS(); F.ctl = (gu32*)(ap->ws + WS_CTL); }
    for (int u = F.tid; u < (LDS_BYTES - LDSCTL_OFF) / 4; u += NTHR) ((LAS unsigned*)(F.lds + LDSCTL_OFF))[u] = 0u;
    __syncthreads();
    const int lo = args.ph_lo, hi = args.ph_hi;
    const bool multi = (hi - lo) > 1;
    XcdBarrier bar; bar.bar = (unsigned*)(F.ctl + CW_BAR); bar.x = 0; bar.st = nullptr;
    if (multi) bar = xcd_barrier_post((unsigned*)(F.ctl + CW_BAR), F.MISC + 8);
#define IN(k) (lo <= (k) && (k) < hi)
#define SEAM(k) do { if (IN(k) && IN((k) + 1)) xcd_barrier(bar); } while (0)
    if (IN(0)) { p0_prologue(F); } SEAM(0);
#pragma unroll
    for (int l0 = 0; l0 < DEPTH; ++l0) {
        const int l = l0;
        const int pb = 1 + 5 * l;
        if (IN(pb)) {
            PHASE_ARGS();
            pg8::Gemm g{FWS(bf16, WS_XB), FWS(bf16, WS_W1T) + (size_t)l * NP * D, T, NP, D}; pg8::StaticOrder S; S.init(T, NP, F.G, (int)blockIdx.x);
            pg8::EpiProj E{FWS(bf16, WS_PROJ), NP, FWS(float, WS_RSS), 1.f / D, EPS};
            pg8::gemm_phase<pg8::EpiProj, pg8::StaticOrder, true, true>(F.lds + RING_OFF, g, S, E);
        } SEAM(pb);
        if (IN(pb + 1)) { m1_naive(F, l); } SEAM(pb + 1);
        if (IN(pb + 2)) { m2_naive(F); } SEAM(pb + 2);
        if (IN(pb + 3)) { m3_naive(F, l); } SEAM(pb + 3);
        if (IN(pb + 4)) {
            PHASE_ARGS();
            pg8::Gemm g{FWS(bf16, WS_MIX), FWS(bf16, WS_W2T) + (size_t)l * D * D, T, D, D}; pg8::StaticOrder S; S.init(T, D, F.G, (int)blockIdx.x);
            pg8::EpiRes E{l == 0 ? FIN(I_X) : (const float*)ap->out, ap->out, FWS(bf16, WS_XB), FWS(float, WS_RSS), D};
            pg8::gemm_phase<pg8::EpiRes, pg8::StaticOrder, true, true>(F.lds + RING_OFF, g, S, E);
        } SEAM(pb + 4);
    }
    if (IN(11)) fn_final(F);
#undef IN
#undef SEAM
}
#ifndef MK_N_LAUNCHES
#define MK_N_LAUNCHES 1
#endif
extern "C" void kernel_launch(void* const* d_in, const int* in_sizes, int n_in, void* d_out, int out_size, void* d_ws, size_t ws_size, hipStream_t stream) {
    static int grid = 0;
    if (grid == 0) {
        if (n_in != 17 || in_sizes[0] != T * D || out_size != T * D || ws_size < WS_END) { fprintf(stderr, "kernel_launch: unexpected shapes: n_in %d in0 %d out %d ws %zu (need %zu); nothing launched\n", n_in, n_in > 0 ? in_sizes[0] : -1, out_size, ws_size, (size_t)WS_END); grid = -1; return; }
        int dev = 0, cus = 0, per_cu = 0;
        if (hipGetDevice(&dev) != hipSuccess || hipDeviceGetAttribute(&cus, hipDeviceAttributeMultiprocessorCount, dev) != hipSuccess) { fprintf(stderr, "kernel_launch: device query failed\n"); grid = -1; return; }
        if (hipFuncSetAttribute((const void*)mk_fwd, hipFuncAttributeMaxDynamicSharedMemorySize, LDS_BYTES) != hipSuccess) { fprintf(stderr, "kernel_launch: hipFuncSetAttribute failed\n"); grid = -1; return; }
        if (hipOccupancyMaxActiveBlocksPerMultiprocessor(&per_cu, (const void*)mk_fwd, NTHR, LDS_BYTES) != hipSuccess || per_cu < 1) fprintf(stderr, "kernel_launch: note: occupancy query reports %d workgroups per CU\n", per_cu);
        (void)hipGetLastError();
        grid = cus;
    }
    if (grid < 0) return;
    if (hipMemsetAsync((char*)d_ws + WS_CTL, 0, CTL_ZERO_BYTES, stream) != hipSuccess) { fprintf(stderr, "kernel_launch: hipMemsetAsync failed\n"); return; }
    Args a{};
    for (int i = 0; i < 17; ++i) a.in[i] = (const float*)d_in[i];
    a.out = (float*)d_out; a.ws = (unsigned char*)d_ws;
    if (MK_N_LAUNCHES == 1) { a.ph_lo = 0; a.ph_hi = N_PHASES; a.li = 0; hipLaunchKernelGGL(mk_fwd, dim3(grid), dim3(NTHR), LDS_BYTES, stream, a); }
    else for (int li = 0; li < N_PHASES; ++li) { a.ph_lo = li; a.ph_hi = li + 1; a.li = li; hipLaunchKernelGGL(mk_fwd, dim3(grid), dim3(NTHR), LDS_BYTES, stream, a); }
    const hipError_t le = hipPeekAtLastError();
    if (le != hipSuccess) fprintf(stderr, "kernel_launch: launch failed: %s (grid %d x %d threads, %d B LDS)\n", hipGetErrorName(le), grid, NTHR, LDS_BYTES);
}
```

```cpp
#include <hip/hip_runtime.h>
#include <cstdio>
#include <cstdint>
namespace pg8 {
#define PG8_LAS __attribute__((address_space(3)))
typedef unsigned short bf16_t;
typedef short bf16x8 __attribute__((ext_vector_type(8)));
typedef float f32x4 __attribute__((ext_vector_type(4)));
typedef unsigned u32x4 __attribute__((ext_vector_type(4)));
constexpr int BM = 256, BK = 64, HALF = 128, HTB = HALF * BK * 2  , STAGE_BYTES = 8 * HTB, NXCD = 8, WGM = 8;

__host__ __device__ __forceinline__ int lds_byte(int r, int c) { const int st = (r >> 4) * 2 + (c >> 5), rr = r & 15, cc = c & 31, ob = rr * 64 + cc * 2; return st * 1024 + (ob ^ (((ob >> 9) & 1) << 5)); }
__host__ __device__ __forceinline__ void stage_rc(int b, int& R, int& C) { const int st = b / 1024, sb = b % 1024, swz = sb ^ (((sb >> 9) & 1) << 5); R = (st >> 1) * 16 + swz / 64; C = (st & 1) * 32 + (swz % 64) / 2; }
__host__ __device__ __forceinline__ int perm32(int rho) { const int n = rho >> 4, i = rho & 15; return 8 * (i >> 2) + 4 * n + (i & 3); }

struct Unit { int pm, pn; };
struct Gemm { const bf16_t* A; const bf16_t* Bt; int M, N, K; };

struct StaticOrder {
    int nM, nN, nwg, G, c;
    __host__ __device__ void init(int M, int N, int G_, int c_) { nM = M / BM; nN = N / BM; nwg = nM * nN; G = G_; c = c_; }
    __host__ __device__ bool next(int i, Unit& u) const {
        const long L = (long)i * G + c; if (L >= nwg) return false;
        int wgid = (int)L; { const int q = nwg / NXCD, r = nwg % NXCD, xcd = wgid % NXCD, off = wgid / NXCD; wgid = (xcd < r ? xcd * (q + 1) : r * (q + 1) + (xcd - r) * q) + off; }
        const int nig = WGM * nN, gid = wgid / nig, fm = gid * WGM, gsz = (nM - fm) < WGM ? (nM - fm) : WGM;
        u.pm = fm + ((wgid % nig) % gsz); u.pn = (wgid % nig) / gsz; return true;
    }
    __device__ __forceinline__ void a_ready(const Unit&) const {}
    __device__ __forceinline__ void done(const Unit&) const {}
};

__device__ __forceinline__ unsigned cvt_pk_bf16(float lo, float hi) { unsigned r; asm volatile("v_cvt_pk_bf16_f32 %0, %1, %2" : "=v"(r) : "v"(lo), "v"(hi)); return r; }
constexpr int EPI_P_OFF = 135168;
struct EpiProj {
    static constexpr bool PERM = true, AFTER_DRAIN = false;
    bf16_t* O; int ldc; const float* rss; float inv_k, eps;
    __device__ __forceinline__ void operator()(const f32x4 (&acc)[2][2][4][2], const Unit& u, int wr, int wc, int fr, int fq, PG8_LAS unsigned char*, int, int) const {
        const int row0 = u.pm * BM + wr * 64 + fr, col0 = u.pn * BM + wc * 32 + 8 * fq;
#pragma unroll
        for (int ai = 0; ai < 2; ++ai)
#pragma unroll
            for (int m = 0; m < 4; ++m) { const int row = row0 + ai * HALF + m * 16; const f32x4 p = *(const f32x4*)(rss + (size_t)row * 4);
                const float rs = __builtin_amdgcn_rsqf(((p[0] + p[1]) + (p[2] + p[3])) * inv_k + eps);
                bf16_t* rowp = O + (size_t)row * ldc + col0;
#pragma unroll
                for (int bj = 0; bj < 2; ++bj) { const f32x4 v0 = acc[ai][bj][m][0] * rs, v1 = acc[ai][bj][m][1] * rs;
                    u32x4 w; w.x = cvt_pk_bf16(v0[0], v0[1]); w.y = cvt_pk_bf16(v0[2], v0[3]); w.z = cvt_pk_bf16(v1[0], v1[1]); w.w = cvt_pk_bf16(v1[2], v1[3]);
                    *(u32x4*)(rowp + bj * HALF) = w; } }
    }
};
struct EpiRes {
    static constexpr bool PERM = false, AFTER_DRAIN = false;
    const float* base; float* out; bf16_t* xb; float* rss; int ldc;
    __device__ __forceinline__ void operator()(const f32x4 (&acc)[2][2][4][2], const Unit& u, int wr, int wc, int fr, int fq, PG8_LAS unsigned char* lds, int wid, int lane) const {
        typedef unsigned u32x2v __attribute__((ext_vector_type(2)));
        PG8_LAS float* P = (PG8_LAS float*)(lds + EPI_P_OFF);
        const int col0 = u.pn * BM + wc * 32 + 4 * fq;
#pragma unroll
        for (int ai = 0; ai < 2; ++ai)
#pragma unroll
            for (int m = 0; m < 4; ++m) { const int r = ai * HALF + wr * 64 + m * 16 + fr; const size_t off = (size_t)(u.pm * BM + r) * ldc + col0; float ss = 0.f;
#pragma unroll
                for (int bj = 0; bj < 2; ++bj)
#pragma unroll
                    for (int n = 0; n < 2; ++n) { const f32x4 bs = *(const f32x4*)(base + off + bj * HALF + n * 16); const f32x4 o = bs + acc[ai][bj][m][n];
                        *(f32x4*)(out + off + bj * HALF + n * 16) = o; ss += (o[0] * o[0] + o[1] * o[1]) + (o[2] * o[2] + o[3] * o[3]);
                        u32x2v w; w.x = cvt_pk_bf16(o[0], o[1]); w.y = cvt_pk_bf16(o[2], o[3]); *(u32x2v*)(xb + off + bj * HALF + n * 16) = w; }
                ss += __shfl_xor(ss, 16); ss += __shfl_xor(ss, 32);
                if (fq == 0) P[r * 4 + wc] = ss;
                if (m & 1) asm volatile("" ::: "memory"); }
        asm volatile("s_waitcnt lgkmcnt(0)" ::: "memory"); __builtin_amdgcn_s_barrier(); asm volatile("" ::: "memory");
        const int tid = wid * 64 + lane;
        if (tid < 256) { const f32x4 p = *(const PG8_LAS f32x4*)(P + tid * 4); rss[(size_t)(u.pm * BM + tid) * 4 + u.pn] = (p[0] + p[1]) + (p[2] + p[3]); }
    }
};
template <class Epi, class Sched, bool ALIGN_EPI = false, bool SP2 = false>
__device__ __forceinline__ void gemm_phase(PG8_LAS unsigned char* lds, const Gemm g, const Sched& S, const Epi& E) {
    const int tid = threadIdx.x, wid = __builtin_amdgcn_readfirstlane(tid >> 6), lane = tid & 63, wr = wid >> 2, wc = wid & 3, fr = lane & 15, fq = lane >> 4;
    const int K = g.K, nt = K / BK;
    unsigned voffA[2], voffB[2];
#pragma unroll
    for (int i = 0; i < 2; ++i) { int R, C; stage_rc(tid * 16 + i * 8192, R, C); const int Rb = Epi::PERM ? ((R & ~31) + perm32(R & 31)) : R;
        voffA[i] = (unsigned)(R * K + C) * 2u; voffB[i] = (unsigned)(Rb * K + C) * 2u; }
    const size_t kstep = (size_t)(BK * 2);
    const size_t hstep = (size_t)HALF * K * 2;
    const size_t tstep = 2 * hstep;
    const unsigned ldsw = (unsigned)wid * 1024u;
    const int aoff = lds_byte(wr * 64 + fr, fq * 8), boff = lds_byte(wc * 32 + fr, fq * 8);
#define PG8_SA(b, h) (((b) * 2 + (h)) * HTB)
#define PG8_SB(b, h) ((4 + (b) * 2 + (h)) * HTB)
#define PG8_STAGE(bufoff, gbase, voff) do { _Pragma("unroll") for (int _i = 0; _i < 2; ++_i) \
        __builtin_amdgcn_global_load_lds((const unsigned*)((const char*)(gbase) + (voff)[_i]), (PG8_LAS unsigned*)(lds + (bufoff) + ldsw + _i * 8192), 16, 0, 0); } while (0)
#define PG8_LDA(dst, b, h) do { _Pragma("unroll") for (int m = 0; m < 4; ++m) _Pragma("unroll") for (int k = 0; k < 2; ++k) dst[m][k] = *(const PG8_LAS bf16x8*)(lds + PG8_SA(b, h) + aoff + m * 2048 + k * 1024); } while (0)
#define PG8_LDB(dst, b, h) do { _Pragma("unroll") for (int n = 0; n < 2; ++n) _Pragma("unroll") for (int k = 0; k < 2; ++k) dst[n][k] = *(const PG8_LAS bf16x8*)(lds + PG8_SB(b, h) + boff + n * 2048 + k * 1024); } while (0)
#define PG8_MMA(ai, bj, At, Bt) do { __builtin_amdgcn_s_setprio(1); _Pragma("unroll") for (int m = 0; m < 4; ++m) _Pragma("unroll") for (int n = 0; n < 2; ++n) _Pragma("unroll") for (int k = 0; k < 2; ++k) \
        acc[ai][bj][m][n] = __builtin_amdgcn_mfma_f32_16x16x32_bf16(Bt[n][k], At[m][k], acc[ai][bj][m][n], 0, 0, 0); __builtin_amdgcn_s_setprio(0); } while (0)
#define PG8_WAIT_V(n) asm volatile("s_waitcnt vmcnt(" #n ")" ::: "memory")
#define PG8_WAIT_L(n) asm volatile("s_waitcnt lgkmcnt(" #n ")" ::: "memory")
#define PG8_BAR __builtin_amdgcn_s_barrier()
#define PG8_SCHED __builtin_amdgcn_sched_barrier(0)
    Unit cur, nxt; int ui = 0;
    if (!S.next(0, cur)) return;
    f32x4 acc[2][2][4][2];
#pragma unroll
    for (int a = 0; a < 2; ++a)
#pragma unroll
        for (int b = 0; b < 2; ++b)
#pragma unroll
            for (int m = 0; m < 4; ++m)
#pragma unroll
                for (int n = 0; n < 2; ++n) acc[a][b][m][n] = (f32x4){0.f, 0.f, 0.f, 0.f};
    bf16x8 At[4][2], B0[2][2], B1[2][2];
    const char* cA = (const char*)g.A + (size_t)cur.pm * tstep; const char* cB = (const char*)g.Bt + (size_t)cur.pn * tstep;
    S.a_ready(cur);
    if constexpr (SP2) {
        PG8_STAGE(PG8_SB(0, 0), cB, voffB); PG8_STAGE(PG8_SB(0, 1), cB + hstep, voffB); PG8_STAGE(PG8_SA(0, 0), cA, voffA); PG8_STAGE(PG8_SA(0, 1), cA + hstep, voffA);
        if (wr == 1) PG8_BAR;
        PG8_WAIT_V(2); PG8_BAR;
        PG8_STAGE(PG8_SB(1, 0), cB + kstep, voffB); PG8_STAGE(PG8_SA(1, 0), cA + kstep, voffA); PG8_STAGE(PG8_SB(1, 1), cB + hstep + kstep, voffB);
        PG8_WAIT_V(6); PG8_BAR;
    } else {
        PG8_STAGE(PG8_SB(0, 0), cB, voffB); PG8_STAGE(PG8_SA(0, 0), cA, voffA); PG8_STAGE(PG8_SB(0, 1), cB + hstep, voffB); PG8_STAGE(PG8_SA(0, 1), cA + hstep, voffA);
        if (wr == 1) PG8_BAR;
        PG8_WAIT_V(4); PG8_BAR;
        PG8_STAGE(PG8_SB(1, 0), cB + kstep, voffB); PG8_STAGE(PG8_SA(1, 0), cA + kstep, voffA); PG8_STAGE(PG8_SB(1, 1), cB + hstep + kstep, voffB);
        PG8_WAIT_V(6); PG8_BAR;
    }
    for (;;) {
        const bool has_next = S.next(ui + 1, nxt);
        const char* nA = has_next ? (const char*)g.A + (size_t)nxt.pm * tstep : cA; const char* nB = has_next ? (const char*)g.Bt + (size_t)nxt.pn * tstep : cB;
        for (int t = 0; t < nt; t += 2) {
            const bool last = (t == nt - 2);
            const char* a1 = cA + (size_t)(t + 1) * kstep;
            const char* a2 = last ? nA : cA + (size_t)(t + 2) * kstep; const char* b2 = last ? nB : cB + (size_t)(t + 2) * kstep;
            const char* a3 = a2 + kstep; const char* b3 = b2 + kstep;
            if (last && has_next) S.a_ready(nxt);
            if constexpr (SP2) {
            PG8_LDB(B0, 0, 0); PG8_LDB(B1, 0, 1); PG8_SCHED; PG8_LDA(At, 0, 0); PG8_STAGE(PG8_SA(1, 1), a1 + hstep, voffA);
            PG8_WAIT_V(8); PG8_WAIT_L(0); PG8_BAR; PG8_MMA(0, 0, At, B0); PG8_MMA(0, 1, At, B1); PG8_BAR; PG8_SCHED;
            PG8_LDA(At, 0, 1); PG8_STAGE(PG8_SB(0, 0), b2, voffB); PG8_STAGE(PG8_SB(0, 1), b2 + hstep, voffB); PG8_STAGE(PG8_SA(0, 0), a2, voffA);
            PG8_WAIT_V(8); PG8_WAIT_L(0); PG8_BAR; PG8_MMA(1, 0, At, B0); PG8_MMA(1, 1, At, B1); PG8_BAR; PG8_SCHED;
            PG8_LDB(B0, 1, 0); PG8_LDB(B1, 1, 1); PG8_SCHED; PG8_LDA(At, 1, 0); PG8_STAGE(PG8_SA(0, 1), a2 + hstep, voffA);
            PG8_WAIT_V(8); PG8_WAIT_L(0); PG8_BAR; PG8_MMA(0, 0, At, B0); PG8_MMA(0, 1, At, B1); PG8_BAR; PG8_SCHED;
            PG8_LDA(At, 1, 1); PG8_STAGE(PG8_SB(1, 0), b3, voffB); PG8_STAGE(PG8_SB(1, 1), b3 + hstep, voffB); PG8_STAGE(PG8_SA(1, 0), a3, voffA);
            PG8_WAIT_V(8); PG8_WAIT_L(0); PG8_BAR; PG8_MMA(1, 0, At, B0); PG8_MMA(1, 1, At, B1); PG8_BAR; PG8_SCHED;
            } else {
            PG8_LDB(B0, 0, 0); PG8_SCHED; PG8_LDA(At, 0, 0); PG8_STAGE(PG8_SA(1, 1), a1 + hstep, voffA);
            PG8_WAIT_L(8); PG8_BAR; PG8_WAIT_L(0); PG8_MMA(0, 0, At, B0); PG8_BAR; PG8_SCHED;
            PG8_LDB(B1, 0, 1); PG8_STAGE(PG8_SB(0, 0), b2, voffB);
            PG8_BAR; PG8_WAIT_L(0); PG8_MMA(0, 1, At, B1); PG8_BAR;
            PG8_LDA(At, 0, 1); PG8_STAGE(PG8_SA(0, 0), a2, voffA);
            PG8_BAR; PG8_WAIT_L(0); PG8_MMA(1, 0, At, B0); PG8_BAR; PG8_SCHED;
            PG8_STAGE(PG8_SB(0, 1), b2 + hstep, voffB);
            PG8_WAIT_V(6); PG8_BAR; PG8_MMA(1, 1, At, B1); PG8_BAR;
            PG8_LDB(B0, 1, 0); PG8_SCHED; PG8_LDA(At, 1, 0); PG8_STAGE(PG8_SA(0, 1), a2 + hstep, voffA);
            PG8_WAIT_L(8); PG8_BAR; PG8_WAIT_L(0); PG8_MMA(0, 0, At, B0); PG8_BAR; PG8_SCHED;
            PG8_LDB(B1, 1, 1); PG8_STAGE(PG8_SB(1, 0), b3, voffB);
            PG8_BAR; PG8_WAIT_L(0); PG8_MMA(0, 1, At, B1); PG8_BAR;
            PG8_LDA(At, 1, 1); PG8_STAGE(PG8_SA(1, 0), a3, voffA);
            PG8_BAR; PG8_WAIT_L(0); PG8_MMA(1, 0, At, B0); PG8_BAR; PG8_SCHED;
            PG8_STAGE(PG8_SB(1, 1), b3 + hstep, voffB);
            PG8_WAIT_V(6); PG8_BAR; PG8_MMA(1, 1, At, B1); PG8_BAR;
            }
        }
        if constexpr (ALIGN_EPI) { if (wr == 0) PG8_BAR; }
        if constexpr (!Epi::AFTER_DRAIN) { E(acc, cur, wr, wc, fr, fq, lds, wid, lane); S.done(cur); }
        if (!has_next) break;
#pragma unroll
        for (int a = 0; a < 2; ++a)
#pragma unroll
            for (int b = 0; b < 2; ++b)
#pragma unroll
                for (int m = 0; m < 4; ++m)
#pragma unroll
                    for (int n = 0; n < 2; ++n) acc[a][b][m][n] = (f32x4){0.f, 0.f, 0.f, 0.f};
        cur = nxt; cA = nA; cB = nB; ++ui;
        if constexpr (ALIGN_EPI) { if (wr == 1) PG8_BAR; }
    }
    PG8_WAIT_V(0);
    if constexpr (!ALIGN_EPI) { if (wr == 0) PG8_BAR; }
    PG8_BAR;
    if constexpr (Epi::AFTER_DRAIN) { E.fused(acc, cur, wr, wc, fr, fq, lds, wid, lane); S.done(cur); }
#undef PG8_SA
#undef PG8_SB
#undef PG8_STAGE
#undef PG8_LDA
#undef PG8_LDB
#undef PG8_MMA
#undef PG8_WAIT_V
#undef PG8_WAIT_L
#undef PG8_BAR
#undef PG8_SCHED
}
}
constexpr int NWAVES = 8, NTHR = NWAVES * 64;
constexpr int T = 32768, D = 1024, SEQ = 8192, NB = 4, CH = 64, NCHUNK = 512, NCB = 128, DEPTH = 2;
constexpr int NP = 3584;
constexpr int DPROJ = 3348;
constexpr float EPS = 1e-6f;
constexpr int C_AH = 0, C_AB = 256, C_AC = 512, C_AZ = 768, C_Q = 1024, C_K = 1152, C_V = 1280, C_GZ = 1536,
              C_PU = 1792, C_PZ = 2048, C_SZ = 2304, C_XS = 2560, C_BM = 2816, C_CM = 3072, C_GATE = 3328, C_DT = 3456;
constexpr int NSTATE = 40960;
constexpr size_t MiB = 1u << 20;
constexpr size_t WS_CTL = 0, CTL_ZERO_BYTES = 1 * MiB;
constexpr size_t WS_W1T = 1 * MiB, WS_W2T = 15 * MiB, WS_PWT = 19 * MiB, WS_RSS = 20 * MiB, WS_DECG = 21 * MiB, WS_DECS = 21 * MiB + 512 * 1024,
                 WS_XB = 32 * MiB, WS_MIX = 96 * MiB, WS_UPD = 160 * MiB, WS_ST = 240 * MiB, WS_PROJ = 280 * MiB, WS_END = 504 * MiB;
constexpr int CW_BAR = 4096;
constexpr int RING_OFF = 0, RING_BYTES = 131072;
constexpr int LDSCTL_OFF = RING_BYTES, MISC_OFF = LDSCTL_OFF + 320;
constexpr int LDS_BYTES = 147456;
static_assert(pg8::EPI_P_OFF >= MISC_OFF + 128 && pg8::EPI_P_OFF + 4096 <= LDS_BYTES, "LDS map");
#define GAS __attribute__((address_space(1)))
#define LAS __attribute__((address_space(3)))
typedef unsigned short bf16;
typedef unsigned v4u __attribute__((ext_vector_type(4)));
typedef float f32x4 __attribute__((ext_vector_type(4)));
typedef short bf16x8 __attribute__((ext_vector_type(8)));
typedef GAS unsigned gu32;
typedef GAS unsigned long long gu64;
#define RLX_AGENT __ATOMIC_RELAXED, __HIP_MEMORY_SCOPE_AGENT
#define LDS_WAIT() asm volatile("s_waitcnt lgkmcnt(0)" ::: "memory")
#define VM_WAIT() asm volatile("s_waitcnt vmcnt(0)" ::: "memory")
__device__ __forceinline__ unsigned long long rt() { return __builtin_amdgcn_s_memrealtime(); }
__device__ __forceinline__ unsigned f2bf(float f) { unsigned u = __builtin_bit_cast(unsigned, f); return (u + 0x7fffu + ((u >> 16) & 1u)) >> 16; }
__device__ __forceinline__ unsigned pk2(float lo, float hi) { return f2bf(lo) | (f2bf(hi) << 16); }

#define XB_TMO      128
#define XB_XCNT(j)  (256  + 64 * (j))
#define XB_XSUB(j)  (1280 + 64 * (j))
#define XB_XGEN(j)  (2304 + 64 * (j))
#define XB_TOP      3328
#define XB_TOPGEN   3392
#define XCD_BAR_WORDS 3456
#define XB_SPIN_CAP (1u << 18)

__device__ __forceinline__ unsigned xb_ld(unsigned* p)              { return __hip_atomic_load(p, __ATOMIC_RELAXED, __HIP_MEMORY_SCOPE_AGENT); }
__device__ __forceinline__ unsigned xb_add(unsigned* p, unsigned v) { return __hip_atomic_fetch_add(p, v, __ATOMIC_RELAXED, __HIP_MEMORY_SCOPE_AGENT); }
__device__ __forceinline__ unsigned xb_xcc_id() { return (unsigned)__builtin_amdgcn_s_getreg((3 << 11) | 20) & 0xFu; }
#define XB_SPIN(cond, bar) do { unsigned _sp = 0; while (cond) { __builtin_amdgcn_s_sleep(1); \
    if ((++_sp & 255u) == 0u) { if (xb_ld(&(bar)[XB_TMO])) break; if (_sp > XB_SPIN_CAP) { atomicAdd(&(bar)[XB_TMO], 1u); break; } } } } while (0)

struct XcdBarrier {
    unsigned* bar; unsigned x;
    volatile LAS unsigned* st;
};

__device__ __forceinline__ XcdBarrier xcd_barrier_post(unsigned* bar, volatile LAS unsigned* st) {
    XcdBarrier b; b.bar = bar; b.x = xb_xcc_id(); b.st = st;
    if (threadIdx.x == 0) (void)xb_add(&bar[XB_XCNT(b.x)], 1u);
    return b;
}
__device__ __forceinline__ void xcd_barrier_complete(unsigned* bar, unsigned x, unsigned& nloc, unsigned& nx) {
    const unsigned G = gridDim.x * gridDim.y * gridDim.z;
    unsigned sum, cnt, mine, sp = 0u;
    for (;;) {
        sum = 0u; cnt = 0u; mine = 0u;
#pragma unroll
        for (unsigned j = 0; j < 16; ++j) { const unsigned c = xb_ld(&bar[XB_XCNT(j)]); sum += c; cnt += (c > 0u) ? 1u : 0u; mine = (j == x) ? c : mine; }
        if (sum == G) break;
        __builtin_amdgcn_s_sleep(1);
        if ((++sp & 255u) == 0u) { if (xb_ld(&bar[XB_TMO])) break; if (sp > XB_SPIN_CAP) { atomicAdd(&bar[XB_TMO], 1u); break; } }
    }
    nloc = mine > 0u ? mine : 1u; nx = cnt > 0u ? cnt : 1u;
}

__device__ __forceinline__ void xcd_barrier(const XcdBarrier& b) {
    asm volatile("s_waitcnt vmcnt(0)" ::: "memory");
    __syncthreads();
    if (threadIdx.x == 0) {
        unsigned* bar = b.bar;
        __builtin_amdgcn_s_waitcnt(0);
        unsigned nloc = b.st[0], nx = b.st[1];
        if (nloc == 0u) { xcd_barrier_complete(bar, b.x, nloc, nx); b.st[0] = nloc; b.st[1] = nx; }
        const unsigned old = xb_add(&bar[XB_XSUB(b.x)], 1u);
        const unsigned gen = old / nloc;
        if (old + 1u == (gen + 1u) * nloc) {
            __builtin_amdgcn_fence(__ATOMIC_RELEASE, "agent");
            asm volatile("s_waitcnt vmcnt(0)" ::: "memory");
            const unsigned og = xb_add(&bar[XB_TOP], 1u);
            const unsigned tg = og / nx;
            if (og + 1u == (tg + 1u) * nx) xb_add(&bar[XB_TOPGEN], 1u);
            else XB_SPIN(xb_ld(&bar[XB_TOPGEN]) == tg, bar);
            __builtin_amdgcn_fence(__ATOMIC_ACQUIRE, "agent");
            xb_add(&bar[XB_XGEN(b.x)], 1u);
            asm volatile("s_waitcnt vmcnt(0)" ::: "memory");
        } else {
            XB_SPIN(xb_ld(&bar[XB_XGEN(b.x)]) == gen, bar);
            __builtin_amdgcn_fence(__ATOMIC_ACQUIRE, "agent");
            asm volatile("s_waitcnt vmcnt(0)" ::: "memory");
        }
    }
    __syncthreads();
}
struct Args { const float* in[17]; float* out; unsigned char* ws; int ph_lo, ph_hi, li, pad; };
enum { I_X = 0, I_NORM_W, I_W_IN, I_CONV_A_W, I_GATE_W, I_GATE_B, I_GLA_NORM_W, I_POOL_W, I_POOL_SCALE, I_SSD_CONV_W, I_SSD_CONV_B, I_SSD_DT_BIAS, I_SSD_A_LOG, I_SSD_D, I_SSD_NORM_W, I_W_OUT, I_FINAL_NORM_W };
typedef const __attribute__((address_space(4))) struct Args* ArgsPfwd;
struct Frame {
    LAS unsigned char* lds;
    volatile LAS unsigned* MISC;
    gu32* ctl;
    ArgsPfwd ap;
    int tid, lane, wave;
    int vcu, G;
};
typedef const __attribute__((address_space(4))) Args* ArgsP;
#define PHASE_ARGS() ArgsP ap = F.ap; asm volatile("" : "+s"(ap))
#define PHASE_BEGIN() Frame F = F0; asm volatile("" : "+v"(F.tid), "+v"(F.lane)); PHASE_ARGS()
#define FIN(i) (ap->in[i])
#define FWS(T_, off) ((T_*)(ap->ws + (off)))
__device__ __forceinline__ float bf2f(unsigned v) { return __uint_as_float(v << 16); }
__device__ __forceinline__ float silu_f(float x) { return x / (1.f + __expf(-x)); }
__device__ __forceinline__ float softplus_f(float x) { return fmaxf(x, 0.f) + log1pf(__expf(-fabsf(x))); }
__device__ __forceinline__ float logsigmoid_f(float x) { return fminf(x, 0.f) - log1pf(__expf(-fabsf(x))); }
__device__ __forceinline__ float wave_sum(float v) {
#pragma unroll
    for (int o = 1; o < 64; o <<= 1) v += __shfl_xor(v, o);
    return v;
}
__device__ __forceinline__ void p0_item(Frame& F, int kind, int l, int kb, int nb, LAS float* scr) {
    PHASE_ARGS();
    const int lane = F.lane, k0 = 64 * kb, n0 = 32 * nb, n = lane & 31, nn = n0 + n;
    if (kind == 0) {
        const float* W = FIN(I_W_IN) + (size_t)l * D * DPROJ; const float* gw = FIN(I_GATE_W) + (size_t)l * 16 * 128; const float* nw = FIN(I_NORM_W) + l * D;
#pragma unroll 4
        for (int i = 0; i < 32; ++i) { const int kk = 2 * i + (lane >> 5), k = k0 + kk; const float* Wr = W + (size_t)k * DPROJ; float v;
            if (nn < 1536) v = Wr[nn];
            else if (nn < 3328) v = Wr[nn + 16];
            else if (nn < 3456) { float s = 0.f;
#pragma unroll
                for (int r = 0; r < 16; ++r) s += Wr[1536 + r] * gw[r * 128 + (nn - 3328)];
                v = s; }
            else if (nn < 3460) v = Wr[3344 + (nn - 3456)];
            else v = 0.f;
            scr[kk * 33 + n] = v * nw[k]; }
    } else {
        const float* W = FIN(I_W_OUT) + (size_t)l * D * D;
#pragma unroll 8
        for (int i = 0; i < 32; ++i) { const int kk = 2 * i + (lane >> 5); scr[kk * 33 + n] = W[(size_t)(k0 + kk) * D + nn]; }
    }
    LDS_WAIT(); asm volatile("" ::: "memory");
    bf16* WT = kind == 0 ? FWS(bf16, WS_W1T) + (size_t)l * NP * D : FWS(bf16, WS_W2T) + (size_t)l * D * D;
    const int c = lane & 7;
#pragma unroll
    for (int j = 0; j < 4; ++j) { const int n2 = (lane >> 3) + 8 * j; const LAS float* s = scr + (8 * c) * 33 + n2;
        v4u o; o.x = pk2(s[0 * 33], s[1 * 33]); o.y = pk2(s[2 * 33], s[3 * 33]); o.z = pk2(s[4 * 33], s[5 * 33]); o.w = pk2(s[6 * 33], s[7 * 33]);
        *(GAS v4u*)(WT + (size_t)(n0 + n2) * D + k0 + 8 * c) = o; }
    LDS_WAIT(); asm volatile("" ::: "memory");
}
__device__ __forceinline__ void p0_prologue(const Frame& F0) {
    PHASE_BEGIN();
    LAS float* scr = (LAS float*)(F.lds + RING_OFF + F.wave * 16384);
    const int gw = F.vcu * NWAVES + F.wave, NGW = F.G * NWAVES;
    constexpr int I_W1 = (D / 64) * (NP / 32), I_W2 = (D / 64) * (D / 32), I_L = I_W1 + I_W2;
    for (int it = gw; it < DEPTH * I_L; it += NGW) {
        const int l = it / I_L; int r = it % I_L;
        if (r < I_W1) p0_item(F, 0, l, r / (NP / 32), r % (NP / 32), scr);
        else { r -= I_W1; p0_item(F, 1, l, r / (D / 32), r % (D / 32), scr); }
    }
    for (int i = (blockIdx.x * NTHR + F.tid); i < DEPTH * 4 * 64 * 64; i += F.G * NTHR) { const int c = i & 63, d = (i >> 6) & 63, lg = i >> 12; FWS(bf16, WS_PWT)[i] = (bf16)f2bf(FIN(I_POOL_W)[(size_t)lg * 4096 + c * 64 + d]); }
    for (int m = gw; m < T; m += NGW) {
        const GAS f32x4* xr = (const GAS f32x4*)(FIN(I_X) + (size_t)m * D) + F.lane; f32x4 v[4]; float s = 0.f;
#pragma unroll
        for (int j = 0; j < 4; ++j) { v[j] = xr[64 * j]; s += (v[j].x * v[j].x + v[j].y * v[j].y) + (v[j].z * v[j].z + v[j].w * v[j].w); }
        s = wave_sum(s);
        GAS unsigned long long* o8 = (GAS unsigned long long*)(FWS(bf16, WS_XB) + (size_t)m * D) + F.lane;
#pragma unroll
        for (int j = 0; j < 4; ++j) o8[64 * j] = (unsigned long long)pk2(v[j].x, v[j].y) | ((unsigned long long)pk2(v[j].z, v[j].w) << 32);
        if (F.lane == 0) *(GAS f32x4*)(FWS(float, WS_RSS) + (size_t)m * 4) = (f32x4){s, 0.f, 0.f, 0.f};
    }
}
__device__ __forceinline__ void fn_final(const Frame& F0) {
    PHASE_BEGIN();
    const int gw = F.vcu * NWAVES + F.wave, NGW = F.G * NWAVES;
    f32x4 w[4];
#pragma unroll
    for (int j = 0; j < 4; ++j) w[j] = ((const GAS f32x4*)FIN(I_FINAL_NORM_W))[F.lane + 64 * j];
    for (int m = gw; m < T; m += NGW) {
        GAS f32x4* xr = (GAS f32x4*)(ap->out + (size_t)m * D) + F.lane; f32x4 v[4]; float s = 0.f;
#pragma unroll
        for (int j = 0; j < 4; ++j) { v[j] = xr[64 * j]; s += (v[j].x * v[j].x + v[j].y * v[j].y) + (v[j].z * v[j].z + v[j].w * v[j].w); }
        const float rstd = rsqrtf(wave_sum(s) * (1.f / D) + EPS);
#pragma unroll
        for (int j = 0; j < 4; ++j) xr[64 * j] = v[j] * rstd * w[j];
    }
}
__device__ __forceinline__ int upd_idx_gla(int h, int vv, int kk) { const int nt = vv >> 5, lane_u = (vv & 31) + 32 * ((kk >> 2) & 1), reg = (kk & 3) + 4 * (kk >> 3); return ((h * 2 + nt) * 16 + reg) * 64 + lane_u; }
__device__ __forceinline__ int upd_idx_ssd(int h, int p, int s) { const int pt = p >> 5, st = s >> 5, s2 = s & 31, reg = (s2 & 3) + 4 * (s2 >> 3), half = (s2 >> 2) & 1, lane_u = (p & 31) + 32 * half; return 8192 + (((h * 2 + pt) * 4 + st) * 16 + reg) * 64 + lane_u; }
__device__ __forceinline__ int st_idx_gla(int h, int vv, int kk) { const int mt = vv >> 5, ks = kk >> 4, lane = (vv & 31) + 32 * ((kk >> 3) & 1), j = kk & 7; return (((h * 2 + mt) * 2 + ks) * 64 + lane) * 8 + j; }
__device__ __forceinline__ int st_idx_ssd(int h, int p, int s) { const int pt = p >> 5, ks = s >> 4, lane = (p & 31) + 32 * ((s >> 3) & 1), j = s & 7; return 8192 + (((h * 2 + pt) * 8 + ks) * 64 + lane) * 8 + j; }
__device__ __forceinline__ float xbc_act(const bf16* PROJ, const float* cw  , const float* cb, int t, int pos, int j) {
    float a = cb[j];
#pragma unroll
    for (int k = 0; k < 4; ++k) { const int d = 3 - k; if (pos - d >= 0) a += cw[k * 768 + j] * bf2f(PROJ[(size_t)(t - d) * NP + C_XS + j]); }
    return silu_f(a);
}
__device__ __forceinline__ void m1_naive(const Frame& F0, int l) {
    PHASE_BEGIN();
    const int tid = F.tid; const bf16* PROJ = FWS(bf16, WS_PROJ); bf16* MIX = FWS(bf16, WS_MIX);
    { const float* cw = FIN(I_CONV_A_W) + l * 3 * 256;
      for (size_t idx = (size_t)blockIdx.x * NTHR + tid; idx < (size_t)T * 256; idx += (size_t)F.G * NTHR) {
        const int ch = idx & 255; const int t = (int)(idx >> 8); const int pos = t & (SEQ - 1); float acc = 0.f;
#pragma unroll
        for (int k = 0; k < 3; ++k) { const int d = 2 - k; if (pos - d >= 0) { const bf16* r = PROJ + (size_t)(t - d) * NP; acc += cw[k * 256 + ch] * (bf2f(r[C_AC + ch]) * bf2f(r[C_AH + ch])); } }
        const bf16* r = PROJ + (size_t)t * NP;
        MIX[(size_t)t * D + ch] = (bf16)f2bf(bf2f(r[C_AB + ch]) * acc * silu_f(bf2f(r[C_AZ + ch]))); } }
    { LAS float* pooled = (LAS float*)F.lds; const float* pw = FIN(I_POOL_W) + l * 4 * 64 * 64; const float* pscale = FIN(I_POOL_SCALE) + l * 256;
      for (int vb = blockIdx.x; vb < T / 2; vb += F.G) {
        const int t = 2 * vb + (tid >> 8), pos = t & (SEQ - 1), ch = tid & 255, g = ch >> 6, win = 2 << g; float s = 0.f; int cnt = 0;
        for (int d = 0; d < win; ++d) if (pos - d >= 0) { s += bf2f(PROJ[(size_t)(t - d) * NP + C_PU + ch]); ++cnt; }
        pooled[tid] = s / (float)cnt - bf2f(PROJ[(size_t)t * NP + C_PU + ch]);
        __syncthreads();
        const int dd = ch & 63; float m = 0.f;
        for (int c = 0; c < 64; ++c) m += pooled[(tid & 256) + g * 64 + c] * pw[(g * 64 + c) * 64 + dd];
        MIX[(size_t)t * D + 512 + ch] = (bf16)f2bf(pscale[ch] * m * silu_f(bf2f(PROJ[(size_t)t * NP + C_PZ + ch])));
        __syncthreads(); } }
    LAS float* la = (LAS float*)F.lds;
    LAS float* tot = (LAS float*)(F.lds + 32768);
    LAS float* w = (LAS float*)(F.lds + 33280);
    LAS float* xsw = (LAS float*)(F.lds + 34816);
    LAS float* bm = (LAS float*)(F.lds + 51200);
    const float* gate_b = FIN(I_GATE_B) + l * 128; const float* cw = FIN(I_SSD_CONV_W) + l * 4 * 768; const float* cb = FIN(I_SSD_CONV_B) + l * 768;
    for (int chunk = blockIdx.x; chunk < NCHUNK; chunk += F.G) {
        const int t0 = chunk * CH;
        for (int i = tid; i < 64 * 128; i += NTHR) { const int c = i >> 7, j = i & 127; la[i] = logsigmoid_f(bf2f(PROJ[(size_t)(t0 + c) * NP + C_GATE + j]) + gate_b[j]) * (1.f / 16.f); }
        __syncthreads();
        if (tid < 128) { float s = 0.f; for (int c = 0; c < 64; ++c) { s += la[c * 128 + tid]; la[c * 128 + tid] = s; } tot[tid] = s; FWS(float, WS_DECG)[chunk * 128 + tid] = __expf(s); }
        __syncthreads();
        for (int i = tid; i < 64 * 128; i += NTHR) { const int c = i >> 7, j = i & 127; la[i] = bf2f(PROJ[(size_t)(t0 + c) * NP + C_K + j]) * __expf(tot[j] - la[i]); }
        __syncthreads();
        for (int o = tid; o < 8192; o += NTHR) { const int h = o >> 11, vv = (o >> 5) & 63, kk = o & 31; float s = 0.f;
            for (int c = 0; c < 64; ++c) s += la[c * 128 + h * 32 + kk] * bf2f(PROJ[(size_t)(t0 + c) * NP + C_V + h * 64 + vv]);
            FWS(float, WS_UPD)[(size_t)chunk * NSTATE + upd_idx_gla(h, vv, kk)] = s; }
        __syncthreads();
        if (tid < 4) { const int h = tid; const float a = -__expf(FIN(I_SSD_A_LOG)[l * 4 + h]); float s = 0.f;
            for (int c = 0; c < 64; ++c) { const float dt = softplus_f(bf2f(PROJ[(size_t)(t0 + c) * NP + C_DT + h]) + FIN(I_SSD_DT_BIAS)[l * 4 + h]); s += dt * a; w[c * 4 + h] = dt; xsw[c * 64 + h] = s; }
            for (int c = 0; c < 64; ++c) w[c * 4 + h] = __expf(s - xsw[c * 64 + h]) * w[c * 4 + h];
            FWS(float, WS_DECS)[chunk * 4 + h] = __expf(s); }
        __syncthreads();
        for (int h = 0; h < 4; ++h) { const int g = h >> 1;
            __syncthreads();
            for (int i = tid; i < 64 * 64; i += NTHR) { const int c = i >> 6, p = i & 63; const int t = t0 + c; xsw[i] = xbc_act(PROJ, cw, cb, t, t & (SEQ - 1), h * 64 + p) * w[c * 4 + h]; }
            if ((h & 1) == 0) for (int i = tid; i < 64 * 128; i += NTHR) { const int c = i >> 7, s = i & 127; const int t = t0 + c; bm[i] = xbc_act(PROJ, cw, cb, t, t & (SEQ - 1), 256 + g * 128 + s); }
            __syncthreads();
            for (int o = tid; o < 8192; o += NTHR) { const int p = o >> 7, s = o & 127; float acc = 0.f;
                for (int c = 0; c < 64; ++c) acc += xsw[c * 64 + p] * bm[c * 128 + s];
                FWS(float, WS_UPD)[(size_t)chunk * NSTATE + upd_idx_ssd(h, p, s)] = acc; } }
        __syncthreads();
    }
}
__device__ __forceinline__ void m2_naive(const Frame& F0) {
    PHASE_BEGIN();
    for (int idx = blockIdx.x * NTHR + F.tid; idx < NB * NSTATE; idx += F.G * NTHR) {
        const int b = idx / NSTATE, e = idx % NSTATE; float s = 0.f; int ui, si, di; bool gla = e < 8192;
        if (gla) { const int h = e >> 11, vv = (e >> 5) & 63, kk = e & 31; ui = upd_idx_gla(h, vv, kk); si = st_idx_gla(h, vv, kk); di = h * 32 + kk; }
        else { const int e2 = e - 8192, h = e2 >> 13, p = (e2 >> 7) & 63, ss = e2 & 127; ui = upd_idx_ssd(h, p, ss); si = st_idx_ssd(h, p, ss); di = h; }
        for (int c = 0; c < NCB; ++c) { const int chunk = b * NCB + c;
            const float dec = gla ? FWS(float, WS_DECG)[chunk * 128 + di] : FWS(float, WS_DECS)[chunk * 4 + di];
            s = dec * s + FWS(float, WS_UPD)[(size_t)chunk * NSTATE + ui];
            FWS(bf16, WS_ST)[(size_t)chunk * NSTATE + si] = (bf16)f2bf(s); } }
}
__device__ __forceinline__ void m3_naive(const Frame& F0, int l) {
    PHASE_BEGIN();
    const int tid = F.tid; const bf16* PROJ = FWS(bf16, WS_PROJ); bf16* MIX = FWS(bf16, WS_MIX);
    LAS float* cm = (LAS float*)F.lds;
    LAS float* red = (LAS float*)(F.lds + 33280);
    const float* cw = FIN(I_SSD_CONV_W) + l * 4 * 768; const float* cb = FIN(I_SSD_CONV_B) + l * 768;
    for (int chunk = blockIdx.x; chunk < NCHUNK; chunk += F.G) {
        const int c = (tid >> 2) & 63, h = tid & 3, t = chunk * CH + c, g = h >> 1;
        if (tid < 256) {
            float q[32];
#pragma unroll
            for (int kk = 0; kk < 32; ++kk) q[kk] = bf2f(PROJ[(size_t)t * NP + C_Q + h * 32 + kk]) * 0.17677669529663687f;
            const bf16* S = FWS(bf16, WS_ST) + (size_t)chunk * NSTATE; float ss = 0.f;
            for (int vv = 0; vv < 64; ++vv) { float o = 0.f;
#pragma unroll
                for (int kk = 0; kk < 32; ++kk) o += q[kk] * bf2f(S[st_idx_gla(h, vv, kk)]);
                ss += o * o; }
            const float rstd = rsqrtf(ss * (1.f / 64.f) + EPS);
            for (int vv = 0; vv < 64; ++vv) { float o = 0.f;
#pragma unroll
                for (int kk = 0; kk < 32; ++kk) o += q[kk] * bf2f(S[st_idx_gla(h, vv, kk)]);
                MIX[(size_t)t * D + 256 + h * 64 + vv] = (bf16)f2bf(o * rstd * FIN(I_GLA_NORM_W)[l * 64 + vv] * silu_f(bf2f(PROJ[(size_t)t * NP + C_GZ + h * 64 + vv]))); }
        }
        float ssum = 0.f;
        for (int pass = 0; pass < 2; ++pass) {
            float rstd = 0.f;
            if (pass == 1) rstd = rsqrtf((red[c * 4 + 0] + red[c * 4 + 1] + red[c * 4 + 2] + red[c * 4 + 3]) * (1.f / 256.f) + EPS);
            for (int gg = 0; gg < 2; ++gg) {
                __syncthreads();
                for (int i = tid; i < 64 * 128; i += NTHR) { const int cc = i >> 7, s = i & 127; const int tt = chunk * CH + cc; cm[cc * 129 + s] = xbc_act(PROJ, cw, cb, tt, tt & (SEQ - 1), 512 + gg * 128 + s); }
                __syncthreads();
                if (tid < 256 && g == gg) {
                    const bf16* S = FWS(bf16, WS_ST) + (size_t)chunk * NSTATE;
                    for (int p = 0; p < 64; ++p) { float y = 0.f;
                        for (int s = 0; s < 128; ++s) y += cm[c * 129 + s] * bf2f(S[st_idx_ssd(h, p, s)]);
                        y += FIN(I_SSD_D)[l * 4 + h] * xbc_act(PROJ, cw, cb, t, t & (SEQ - 1), h * 64 + p);
                        y *= silu_f(bf2f(PROJ[(size_t)t * NP + C_SZ + h * 64 + p]));
                        if (pass == 0) ssum += y * y; else MIX[(size_t)t * D + 768 + h * 64 + p] = (bf16)f2bf(y * rstd * FIN(I_SSD_NORM_W)[l * 256 + h * 64 + p]); } }
            }
            if (pass == 0 && tid < 256) red[c * 4 + h] = ssum;
            __syncthreads();
        }
    }
}
typedef short s16x4 __attribute__((ext_vector_type(4)));
typedef float f32x16 __attribute__((ext_vector_type(16)));
typedef unsigned u32x2 __attribute__((ext_vector_type(2)));
constexpr int PT_TR256 = 576, PT_TR128 = 320;
constexpr int PT_ROW256 = 528, PT_ROW128 = 272;
__device__ __forceinline__ s16x4 tr16(LAS unsigned char* p) { return __builtin_bit_cast(s16x4, __builtin_amdgcn_ds_read_tr16_b64_v4i16((LAS s16x4*)p)); }
__device__ __forceinline__ bf16x8 tr_frag(LAS unsigned char* tile, int pitch, int k0, int col0, int lane) {
    const int h = lane >> 5, blk = (lane >> 4) & 1, q = (lane & 15) >> 2, p = lane & 3;
    LAS unsigned char* a = tile + (k0 + 8 * h + q) * pitch + (col0 + 16 * blk + 4 * p) * 2;
    const s16x4 lo = tr16(a), hi = tr16(a + 4 * pitch);
    return (bf16x8){lo[0], lo[1], lo[2], lo[3], hi[0], hi[1], hi[2], hi[3]};
}
__device__ __forceinline__ void unpack8(const v4u w, float (&f)[8]) {
#pragma unroll
    for (int i = 0; i < 4; ++i) { f[2 * i] = __uint_as_float(w[i] << 16); f[2 * i + 1] = __uint_as_float(w[i] & 0xffff0000u); }
}
__device__ __forceinline__ void unpack4(const u32x2 w, float (&f)[4]) { f[0] = __uint_as_float(w.x << 16); f[1] = __uint_as_float(w.x & 0xffff0000u); f[2] = __uint_as_float(w.y << 16); f[3] = __uint_as_float(w.y & 0xffff0000u); }
__device__ __forceinline__ v4u pack8(const float (&f)[8]) { v4u o; o.x = pk2(f[0], f[1]); o.y = pk2(f[2], f[3]); o.z = pk2(f[4], f[5]); o.w = pk2(f[6], f[7]); return o; }
__device__ __forceinline__ float silu_fast(float x) { return x * __builtin_amdgcn_rcpf(1.f + __expf(-x)); }
__device__ __forceinline__ float logsigmoid_fast(float x) { return fminf(x, 0.f) - __logf(1.f + __expf(-fabsf(x))); }
#define STEP_BEGIN() ArgsP ap = F.ap; asm volatile("" : "+s"(ap)); int tid = F.tid; asm volatile("" : "+v"(tid)); const int lane = tid & 63; (void)lane
#define MFMA32(a, b, c) __builtin_amdgcn_mfma_f32_32x32x16_bf16((a), (b), (c), 0, 0, 0)

struct Conv8 { float w[4][8]; float b[8]; };
__device__ __forceinline__ void conv8_load(Conv8& cv, const float* cw  , const float* cb, int jsrc) {
#pragma unroll
    for (int k = 0; k < 4; ++k) { const f32x4 a = *(const f32x4*)(cw + k * 768 + jsrc), b = *(const f32x4*)(cw + k * 768 + jsrc + 4);
        cv.w[k][0] = a[0]; cv.w[k][1] = a[1]; cv.w[k][2] = a[2]; cv.w[k][3] = a[3]; cv.w[k][4] = b[0]; cv.w[k][5] = b[1]; cv.w[k][6] = b[2]; cv.w[k][7] = b[3]; }
    const f32x4 a = *(const f32x4*)(cb + jsrc), b = *(const f32x4*)(cb + jsrc + 4);
    cv.b[0] = a[0]; cv.b[1] = a[1]; cv.b[2] = a[2]; cv.b[3] = a[3]; cv.b[4] = b[0]; cv.b[5] = b[1]; cv.b[6] = b[2]; cv.b[7] = b[3];
}

__device__ __forceinline__ void m1_fast(const Frame& F0, int l) {
    const Frame& F = F0;
    const int wave = F.wave;
    LAS unsigned char* lds = F.lds;
    for (int chunk = blockIdx.x; chunk < NCHUNK; chunk += F.G) {
        const int t0 = chunk * CH, pos0 = t0 & (SEQ - 1); const bool first = pos0 == 0;
        { STEP_BEGIN();
          const bf16* P0 = FWS(bf16, WS_PROJ) + (size_t)t0 * NP; bf16* MX = FWS(bf16, WS_MIX) + (size_t)t0 * D; float* UP = FWS(float, WS_UPD) + (size_t)chunk * NSTATE; (void)P0; (void)MX; (void)UP;
          const int cg = tid & 31, r0 = 4 * (tid >> 5); const float* cw = FIN(I_CONV_A_W) + l * 768 + 8 * cg;
          float w0[8], w1[8], w2[8];
          { const f32x4 a = *(const f32x4*)(cw), b = *(const f32x4*)(cw + 4), c = *(const f32x4*)(cw + 256), d = *(const f32x4*)(cw + 260), e = *(const f32x4*)(cw + 512), f = *(const f32x4*)(cw + 516);
#pragma unroll
            for (int i = 0; i < 4; ++i) { w0[i] = a[i]; w0[4 + i] = b[i]; w1[i] = c[i]; w1[4 + i] = d[i]; w2[i] = e[i]; w2[4 + i] = f[i]; } }
          float u[6][8];
#pragma unroll
          for (int i = 0; i < 6; ++i) { const int row = r0 - 2 + i;
              if (first && row < 0) {
#pragma unroll
                  for (int e = 0; e < 8; ++e) u[i][e] = 0.f; }
              else { const bf16* rp = P0 + (ptrdiff_t)row * NP + 8 * cg; float hf[8], cf[8]; unpack8(*(const v4u*)(rp + C_AH), hf); unpack8(*(const v4u*)(rp + C_AC), cf);
#pragma unroll
                  for (int e = 0; e < 8; ++e) u[i][e] = hf[e] * cf[e]; } }
#pragma unroll
          for (int r = 0; r < 4; ++r) { const bf16* rp = P0 + (size_t)(r0 + r) * NP + 8 * cg; float bf[8], zf[8], y[8]; unpack8(*(const v4u*)(rp + C_AB), bf); unpack8(*(const v4u*)(rp + C_AZ), zf);
#pragma unroll
              for (int e = 0; e < 8; ++e) y[e] = bf[e] * (w0[e] * u[r][e] + w1[e] * u[r + 1][e] + w2[e] * u[r + 2][e]) * silu_fast(zf[e]);
              *(v4u*)(MX + (size_t)(r0 + r) * D + 8 * cg) = pack8(y); } }
        { STEP_BEGIN();
          const bf16* P0 = FWS(bf16, WS_PROJ) + (size_t)t0 * NP; bf16* MX = FWS(bf16, WS_MIX) + (size_t)t0 * D; float* UP = FWS(float, WS_UPD) + (size_t)chunk * NSTATE; (void)P0; (void)MX; (void)UP;
          LAS float* SEG = (LAS float*)lds;
          LAS unsigned char* KD = lds + 2048;
          LAS unsigned char* VT = lds + 2048 + 64 * PT_TR128;
          const int j = tid & 127, seg = tid >> 7;
          float gl[16], kf[16];
#pragma unroll
          for (int i = 0; i < 16; ++i) { const bf16* rp = P0 + (size_t)(16 * seg + i) * NP; gl[i] = bf2f(rp[C_GATE + j]); kf[i] = bf2f(rp[C_K + j]); }
          v4u vp[4];
#pragma unroll
          for (int i = 0; i < 4; ++i) { const int piece = tid + NTHR * i, row = piece >> 5, pc = piece & 31; vp[i] = *(const v4u*)(P0 + (size_t)row * NP + C_V + 8 * pc); }
          const float gb = FIN(I_GATE_B)[l * 128 + j]; float run = 0.f;
#pragma unroll
          for (int i = 0; i < 16; ++i) { run += logsigmoid_fast(gl[i] + gb) * (1.f / 16.f); gl[i] = run; }
          SEG[seg * 128 + j] = run;
#pragma unroll
          for (int i = 0; i < 4; ++i) { const int piece = tid + NTHR * i, row = piece >> 5, pc = piece & 31; *(LAS v4u*)(VT + row * PT_TR256 + pc * 16) = vp[i]; }
          __syncthreads();
          const float s0 = SEG[j], s1 = SEG[128 + j], s2 = SEG[256 + j], s3 = SEG[384 + j];
          const float total = (s0 + s1) + (s2 + s3), prefix = seg == 0 ? 0.f : (seg == 1 ? s0 : (seg == 2 ? s0 + s1 : s0 + s1 + s2));
#pragma unroll
          for (int i = 0; i < 16; ++i) *(LAS unsigned short*)(KD + (16 * seg + i) * PT_TR128 + 2 * j) = (unsigned short)f2bf(kf[i] * __expf(total - (prefix + gl[i])));
          if (seg == 0) FWS(float, WS_DECG)[chunk * 128 + j] = __expf(total);
          __syncthreads();
          const int h = wave >> 1, nt = wave & 1; f32x16 acc;
#pragma unroll
          for (int r = 0; r < 16; ++r) acc[r] = 0.f;
#pragma unroll
          for (int ks = 0; ks < 4; ++ks) { const bf16x8 a = tr_frag(KD, PT_TR128, 16 * ks, h * 32, lane), b = tr_frag(VT, PT_TR256, 16 * ks, h * 64 + nt * 32, lane); acc = MFMA32(a, b, acc); }
          float* up = UP + ((h * 2 + nt) * 16) * 64 + lane;
#pragma unroll
          for (int r = 0; r < 16; ++r) up[r * 64] = acc[r];
          __syncthreads(); }
        { STEP_BEGIN();
          const bf16* P0 = FWS(bf16, WS_PROJ) + (size_t)t0 * NP; bf16* MX = FWS(bf16, WS_MIX) + (size_t)t0 * D; float* UP = FWS(float, WS_UPD) + (size_t)chunk * NSTATE; (void)P0; (void)MX; (void)UP;
          LAS float* WL = (LAS float*)lds;
          LAS unsigned char* XSW = lds + 1024;
          LAS unsigned char* BM = lds + 1024 + 64 * PT_TR256;
          const int cg = tid & 63, r0 = 8 * (tid >> 6), jc = 8 * cg;
          v4u xr[11];
#pragma unroll
          for (int i = 0; i < 11; ++i) { const int row = r0 - 3 + i; xr[i] = (first && row < 0) ? (v4u){0u, 0u, 0u, 0u} : *(const v4u*)(P0 + (ptrdiff_t)row * NP + C_XS + jc); }
          Conv8 cv; conv8_load(cv, FIN(I_SSD_CONV_W) + l * 4 * 768, FIN(I_SSD_CONV_B) + l * 768, jc);
          if (wave == 0) {
              const u32x2 dp = *(const u32x2*)(P0 + (size_t)lane * NP + C_DT); float dpf[4]; unpack4(dp, dpf);
#pragma unroll
              for (int h = 0; h < 4; ++h) { const float dt = softplus_f(dpf[h] + FIN(I_SSD_DT_BIAS)[l * 4 + h]), a = -__expf(FIN(I_SSD_A_LOG)[l * 4 + h]); float x = dt * a;
#pragma unroll
                  for (int o = 1; o < 64; o <<= 1) { const float y = __shfl_up(x, o); if (lane >= o) x += y; }
                  const float total = __shfl(x, 63);
                  WL[lane * 4 + h] = __expf(total - x) * dt;
                  if (lane == 63) FWS(float, WS_DECS)[chunk * 4 + h] = __expf(total); } }
          __syncthreads();
          { const bool is_xs = cg < 32; const int hh = cg >> 3;
#pragma unroll
            for (int r = 0; r < 8; ++r) { float a[8], x0[8], x1[8], x2[8], x3[8]; unpack8(xr[r], x0); unpack8(xr[r + 1], x1); unpack8(xr[r + 2], x2); unpack8(xr[r + 3], x3);
                const float wl = is_xs ? WL[(r0 + r) * 4 + hh] : 1.f;
#pragma unroll
                for (int e = 0; e < 8; ++e) a[e] = silu_fast(cv.b[e] + cv.w[0][e] * x0[e] + cv.w[1][e] * x1[e] + cv.w[2][e] * x2[e] + cv.w[3][e] * x3[e]) * wl;
                *(LAS v4u*)((is_xs ? XSW : BM - 512) + (r0 + r) * PT_TR256 + jc * 2) = pack8(a); } }
          __syncthreads();
          const int h = wave >> 1, pt = wave & 1, g = h >> 1; f32x16 acc[4];
#pragma unroll
          for (int st = 0; st < 4; ++st)
#pragma unroll
              for (int r = 0; r < 16; ++r) acc[st][r] = 0.f;
#pragma unroll
          for (int ks = 0; ks < 4; ++ks) { const bf16x8 b = tr_frag(XSW, PT_TR256, 16 * ks, h * 64 + pt * 32, lane);
#pragma unroll
              for (int st = 0; st < 4; ++st) { const bf16x8 a = tr_frag(BM, PT_TR256, 16 * ks, g * 128 + st * 32, lane); acc[st] = MFMA32(a, b, acc[st]); } }
          float* up = UP + 8192 + (((h * 2 + pt) * 4) * 16) * 64 + lane;
#pragma unroll
          for (int st = 0; st < 4; ++st)
#pragma unroll
              for (int r = 0; r < 16; ++r) up[(st * 16 + r) * 64] = acc[st][r];
          __syncthreads(); }
        { STEP_BEGIN();
          const bf16* P0 = FWS(bf16, WS_PROJ) + (size_t)t0 * NP; bf16* MX = FWS(bf16, WS_MIX) + (size_t)t0 * D; float* UP = FWS(float, WS_UPD) + (size_t)chunk * NSTATE; (void)P0; (void)MX; (void)UP;
          LAS unsigned char* U = lds;
          LAS unsigned char* PA = lds + 79 * PT_ROW256;
          LAS unsigned char* Z = PA + 64 * PT_ROW256;
#pragma unroll
          for (int i = 0; i < 5; ++i) { const int piece = tid + NTHR * i; if (piece < 79 * 32) { const int ur = piece >> 5, pc = piece & 31;
              const v4u v = (first && ur < 15) ? (v4u){0u, 0u, 0u, 0u} : *(const v4u*)(P0 + (ptrdiff_t)(ur - 15) * NP + C_PU + 8 * pc);
              *(LAS v4u*)(U + ur * PT_ROW256 + pc * 16) = v; } }
#pragma unroll
          for (int i = 0; i < 4; ++i) { const int piece = tid + NTHR * i, row = piece >> 5, pc = piece & 31; *(LAS v4u*)(Z + row * PT_ROW256 + pc * 16) = *(const v4u*)(P0 + (size_t)row * NP + C_PZ + 8 * pc); }
          __syncthreads();
          { const int g = wave >> 1, t = tid & 127, cgl = t & 7, r0 = 4 * (t >> 3), win = 2 << g, colb = (g * 64 + 8 * cgl) * 2;
            float S[8], cur[8];
#pragma unroll
            for (int e = 0; e < 8; ++e) S[e] = 0.f;
            for (int d = 0; d < win; ++d) { float x[8]; unpack8(*(LAS const v4u*)(U + (r0 + 15 - d) * PT_ROW256 + colb), x);
#pragma unroll
                for (int e = 0; e < 8; ++e) S[e] += x[e]; }
#pragma unroll
            for (int r = 0; r < 4; ++r) { unpack8(*(LAS const v4u*)(U + (r0 + r + 15) * PT_ROW256 + colb), cur);
                if (r > 0) { float old[8]; unpack8(*(LAS const v4u*)(U + (r0 + r + 15 - win) * PT_ROW256 + colb), old);
#pragma unroll
                    for (int e = 0; e < 8; ++e) S[e] += cur[e] - old[e]; }
                const int pos = pos0 + r0 + r; const float inv = 1.f / (float)(pos + 1 < win ? pos + 1 : win); float pl[8];
#pragma unroll
                for (int e = 0; e < 8; ++e) pl[e] = S[e] * inv - cur[e];
                *(LAS v4u*)(PA + (r0 + r) * PT_ROW256 + colb) = pack8(pl); } }
          __syncthreads();
          { const int g = wave >> 1, mt = wave & 1, lm = lane & 31, hf = lane >> 5; f32x16 acc[2];
#pragma unroll
            for (int tt = 0; tt < 2; ++tt)
#pragma unroll
                for (int r = 0; r < 16; ++r) acc[tt][r] = 0.f;
            const bf16* pw = FWS(bf16, WS_PWT) + (size_t)((l * 4 + g) * 64 + mt * 32 + lm) * 64 + 8 * hf;
#pragma unroll
            for (int ks = 0; ks < 4; ++ks) { const bf16x8 a = *(const bf16x8*)(pw + ks * 16);
#pragma unroll
                for (int tt = 0; tt < 2; ++tt) { const bf16x8 b = *(LAS const bf16x8*)(PA + (tt * 32 + lm) * PT_ROW256 + (g * 64 + ks * 16 + 8 * hf) * 2); acc[tt] = MFMA32(a, b, acc[tt]); } }
            const float* ps = FIN(I_POOL_SCALE) + l * 256;
#pragma unroll
            for (int tt = 0; tt < 2; ++tt)
#pragma unroll
                for (int rq = 0; rq < 4; ++rq) { const int tok = tt * 32 + lm, ch = g * 64 + mt * 32 + 8 * rq + 4 * hf; LAS u32x2* zp = (LAS u32x2*)(Z + tok * PT_ROW256 + ch * 2);
                    float zf[4]; unpack4(*zp, zf); const f32x4 sc = *(const f32x4*)(ps + ch);
                    u32x2 o; o.x = pk2(sc[0] * acc[tt][4 * rq + 0] * silu_fast(zf[0]), sc[1] * acc[tt][4 * rq + 1] * silu_fast(zf[1])); o.y = pk2(sc[2] * acc[tt][4 * rq + 2] * silu_fast(zf[2]), sc[3] * acc[tt][4 * rq + 3] * silu_fast(zf[3]));
                    *zp = o; } }
          __syncthreads();
#pragma unroll
          for (int i = 0; i < 4; ++i) { const int piece = tid + NTHR * i, row = piece >> 5, pc = piece & 31; *(v4u*)(MX + (size_t)row * D + 512 + 8 * pc) = *(LAS const v4u*)(Z + row * PT_ROW256 + pc * 16); }
          __syncthreads(); }
    }
}
__device__ __forceinline__ void m2_fast(const Frame& F0) {
    PHASE_BEGIN();
    constexpr int NPAIR = NSTATE / 2, PER_WG = 320;
    if (F.tid < PER_WG)
    for (int item = blockIdx.x * PER_WG + F.tid; item < NB * NPAIR; item += F.G * PER_WG) {
        const int b = item / NPAIR, pi = item % NPAIR, m = pi & 31, h2 = (pi >> 5) & 1, jp = (pi >> 6) & 3, frag = pi >> 8;
        const int e0 = frag * 512 + (h2 * 32 + m) * 8 + 2 * jp;
        int u0, d0, d1, dstride; const float* dbase;
        if (frag < 16) { const int ks = frag & 1, mt = (frag >> 1) & 1, h = frag >> 2, vv = mt * 32 + m, kk = ks * 16 + 8 * h2 + 2 * jp;
            u0 = upd_idx_gla(h, vv, kk); d0 = h * 32 + kk; d1 = d0 + 1; dstride = 128; dbase = FWS(float, WS_DECG); }
        else { const int f = frag - 16, ks = f & 7, pt = (f >> 3) & 1, h = f >> 4, p = pt * 32 + m, s = ks * 16 + 8 * h2 + 2 * jp;
            u0 = upd_idx_ssd(h, p, s); d0 = h; d1 = h; dstride = 4; dbase = FWS(float, WS_DECS); }
        const float* up = FWS(float, WS_UPD) + (size_t)b * NCB * NSTATE + u0;
        unsigned* sp = (unsigned*)(FWS(bf16, WS_ST) + (size_t)b * NCB * NSTATE + e0);
        const float* dp = dbase + (size_t)b * NCB * dstride;
        float s0 = 0.f, s1 = 0.f;
#pragma unroll 1
        for (int c = 0; c < NCB; c += 8) { float ua[8], ub[8], da[8], db[8];
#pragma unroll
            for (int i = 0; i < 8; ++i) { ua[i] = up[(size_t)(c + i) * NSTATE]; ub[i] = up[(size_t)(c + i) * NSTATE + 64]; da[i] = dp[(c + i) * dstride + d0]; db[i] = dp[(c + i) * dstride + d1]; }
#pragma unroll
            for (int i = 0; i < 8; ++i) { s0 = da[i] * s0 + ua[i]; s1 = db[i] * s1 + ub[i]; sp[(size_t)(c + i) * (NSTATE / 2)] = pk2(s0, s1); } }
    }
}
__device__ __forceinline__ void m3_fast(const Frame& F0, int l) {
    const Frame& F = F0;
    const int wave = F.wave;
    LAS unsigned char* lds = F.lds;
    for (int chunk = blockIdx.x; chunk < NCHUNK; chunk += F.G) {
        const int t0 = chunk * CH; const bool first = (t0 & (SEQ - 1)) == 0;
        const int h = wave >> 1, ct = wave & 1;
        { STEP_BEGIN(); const int lm = lane & 31, hf = lane >> 5, tok = ct * 32 + lm;
          const bf16* P0 = FWS(bf16, WS_PROJ) + (size_t)t0 * NP; bf16* MX = FWS(bf16, WS_MIX) + (size_t)t0 * D; const bf16* STC = FWS(bf16, WS_ST) + (size_t)chunk * NSTATE;
          LAS unsigned char* Q = lds;
          LAS unsigned char* GZ = lds + 64 * PT_ROW128;
          bf16x8 a[2][2];
#pragma unroll
          for (int mt = 0; mt < 2; ++mt)
#pragma unroll
              for (int ks = 0; ks < 2; ++ks) a[mt][ks] = *(const bf16x8*)(STC + ((((h * 2 + mt) * 2 + ks) * 64 + lane) * 8));
#pragma unroll
          for (int i = 0; i < 2; ++i) { const int piece = tid + NTHR * i, row = piece >> 4, pc = piece & 15; *(LAS v4u*)(Q + row * PT_ROW128 + pc * 16) = *(const v4u*)(P0 + (size_t)row * NP + C_Q + 8 * pc); }
#pragma unroll
          for (int i = 0; i < 4; ++i) { const int piece = tid + NTHR * i, row = piece >> 5, pc = piece & 31; *(LAS v4u*)(GZ + row * PT_ROW256 + pc * 16) = *(const v4u*)(P0 + (size_t)row * NP + C_GZ + 8 * pc); }
          __syncthreads();
          f32x16 acc[2];
#pragma unroll
          for (int mt = 0; mt < 2; ++mt)
#pragma unroll
              for (int r = 0; r < 16; ++r) acc[mt][r] = 0.f;
#pragma unroll
          for (int ks = 0; ks < 2; ++ks) { const bf16x8 b = *(LAS const bf16x8*)(Q + tok * PT_ROW128 + (h * 32 + ks * 16 + 8 * hf) * 2);
#pragma unroll
              for (int mt = 0; mt < 2; ++mt) acc[mt] = MFMA32(a[mt][ks], b, acc[mt]); }
          float ss = 0.f;
#pragma unroll
          for (int mt = 0; mt < 2; ++mt)
#pragma unroll
              for (int r = 0; r < 16; ++r) { acc[mt][r] *= 0.17677669529663687f; ss += acc[mt][r] * acc[mt][r]; }
          ss += __shfl_xor(ss, 32);
          const float rstd = rsqrtf(ss * (1.f / 64.f) + EPS); const float* gnw = FIN(I_GLA_NORM_W) + l * 64;
#pragma unroll
          for (int mt = 0; mt < 2; ++mt)
#pragma unroll
              for (int rq = 0; rq < 4; ++rq) { const int vv = mt * 32 + 8 * rq + 4 * hf; LAS u32x2* zp = (LAS u32x2*)(GZ + tok * PT_ROW256 + (h * 64 + vv) * 2);
                  float zf[4]; unpack4(*zp, zf); const f32x4 gw = *(const f32x4*)(gnw + vv);
                  u32x2 o; o.x = pk2(acc[mt][4 * rq + 0] * rstd * gw[0] * silu_fast(zf[0]), acc[mt][4 * rq + 1] * rstd * gw[1] * silu_fast(zf[1]));
                  o.y = pk2(acc[mt][4 * rq + 2] * rstd * gw[2] * silu_fast(zf[2]), acc[mt][4 * rq + 3] * rstd * gw[3] * silu_fast(zf[3]));
                  *zp = o; }
          __syncthreads();
#pragma unroll
          for (int i = 0; i < 4; ++i) { const int piece = tid + NTHR * i, row = piece >> 5, pc = piece & 31; *(v4u*)(MX + (size_t)row * D + 256 + 8 * pc) = *(LAS const v4u*)(GZ + row * PT_ROW256 + pc * 16); }
          __syncthreads(); }
        { STEP_BEGIN(); const int lm = lane & 31, hf = lane >> 5, tok = ct * 32 + lm;
          const bf16* P0 = FWS(bf16, WS_PROJ) + (size_t)t0 * NP; bf16* MX = FWS(bf16, WS_MIX) + (size_t)t0 * D; const bf16* STC = FWS(bf16, WS_ST) + (size_t)chunk * NSTATE;
          LAS unsigned char* XS = lds;
          LAS unsigned char* CM = lds + 64 * PT_ROW256;
          LAS unsigned char* SZ = lds + 2 * 64 * PT_ROW256;
          LAS float* RED = (LAS float*)(lds + 3 * 64 * PT_ROW256);
          const int g = h >> 1;
          bf16x8 a[2][8];
#pragma unroll
          for (int pt = 0; pt < 2; ++pt)
#pragma unroll
              for (int ks = 0; ks < 8; ++ks) a[pt][ks] = *(const bf16x8*)(STC + 8192 + ((((h * 2 + pt) * 8 + ks) * 64 + lane) * 8));
          { const int cg = tid & 63, r0 = 8 * (tid >> 6), jc = 8 * cg, jsrc = cg < 32 ? jc : jc + 256;
            v4u xr[11];
#pragma unroll
            for (int i = 0; i < 11; ++i) { const int row = r0 - 3 + i; xr[i] = (first && row < 0) ? (v4u){0u, 0u, 0u, 0u} : *(const v4u*)(P0 + (ptrdiff_t)row * NP + C_XS + jsrc); }
            Conv8 cv; conv8_load(cv, FIN(I_SSD_CONV_W) + l * 4 * 768, FIN(I_SSD_CONV_B) + l * 768, jsrc);
#pragma unroll
            for (int i = 0; i < 4; ++i) { const int piece = tid + NTHR * i, row = piece >> 5, pc = piece & 31; *(LAS v4u*)(SZ + row * PT_ROW256 + pc * 16) = *(const v4u*)(P0 + (size_t)row * NP + C_SZ + 8 * pc); }
#pragma unroll
            for (int r = 0; r < 8; ++r) { float o[8], x0[8], x1[8], x2[8], x3[8]; unpack8(xr[r], x0); unpack8(xr[r + 1], x1); unpack8(xr[r + 2], x2); unpack8(xr[r + 3], x3);
#pragma unroll
                for (int e = 0; e < 8; ++e) o[e] = silu_fast(cv.b[e] + cv.w[0][e] * x0[e] + cv.w[1][e] * x1[e] + cv.w[2][e] * x2[e] + cv.w[3][e] * x3[e]);
                *(LAS v4u*)((cg < 32 ? XS : CM - 512) + (r0 + r) * PT_ROW256 + jc * 2) = pack8(o); } }
          __syncthreads();
          f32x16 acc[2];
#pragma unroll
          for (int pt = 0; pt < 2; ++pt)
#pragma unroll
              for (int r = 0; r < 16; ++r) acc[pt][r] = 0.f;
#pragma unroll
          for (int ks = 0; ks < 8; ++ks) { const bf16x8 b = *(LAS const bf16x8*)(CM + tok * PT_ROW256 + (g * 128 + ks * 16 + 8 * hf) * 2);
#pragma unroll
              for (int pt = 0; pt < 2; ++pt) acc[pt] = MFMA32(a[pt][ks], b, acc[pt]); }
          const float dsk = FIN(I_SSD_D)[l * 4 + h]; float ss = 0.f;
#pragma unroll
          for (int pt = 0; pt < 2; ++pt)
#pragma unroll
              for (int rq = 0; rq < 4; ++rq) { const int ch = h * 64 + pt * 32 + 8 * rq + 4 * hf; float xf[4], zf[4]; unpack4(*(LAS const u32x2*)(XS + tok * PT_ROW256 + ch * 2), xf); unpack4(*(LAS const u32x2*)(SZ + tok * PT_ROW256 + ch * 2), zf);
#pragma unroll
                  for (int e = 0; e < 4; ++e) { const float y = (acc[pt][4 * rq + e] + dsk * xf[e]) * silu_fast(zf[e]); acc[pt][4 * rq + e] = y; ss += y * y; } }
          ss += __shfl_xor(ss, 32);
          if (hf == 0) RED[tok * 4 + h] = ss;
          __syncthreads();
          const f32x4 rd = *(LAS const f32x4*)(RED + tok * 4); const float rstd = rsqrtf(((rd[0] + rd[1]) + (rd[2] + rd[3])) * (1.f / 256.f) + EPS); const float* snw = FIN(I_SSD_NORM_W) + l * 256;
#pragma unroll
          for (int pt = 0; pt < 2; ++pt)
#pragma unroll
              for (int rq = 0; rq < 4; ++rq) { const int ch = h * 64 + pt * 32 + 8 * rq + 4 * hf; const f32x4 nw = *(const f32x4*)(snw + ch);
                  u32x2 o; o.x = pk2(acc[pt][4 * rq + 0] * rstd * nw[0], acc[pt][4 * rq + 1] * rstd * nw[1]); o.y = pk2(acc[pt][4 * rq + 2] * rstd * nw[2], acc[pt][4 * rq + 3] * rstd * nw[3]);
                  *(LAS u32x2*)(SZ + tok * PT_ROW256 + ch * 2) = o; }
          __syncthreads();
#pragma unroll
          for (int i = 0; i < 4; ++i) { const int piece = tid + NTHR * i, row = piece >> 5, pc = piece & 31; *(v4u*)(MX + (size_t)row * D + 768 + 8 * pc) = *(LAS const v4u*)(SZ + row * PT_ROW256 + pc * 16); }
          __syncthreads(); }
    }
}
#ifndef M1_FAST
#define M1_FAST 1
#endif
#ifndef M2_FAST
#define M2_FAST 1
#endif
#ifndef M3_FAST
#define M3_FAST 1
#endif
constexpr int N_PHASES = 12;
#define IN(k) (lo <= (k) && (k) < hi)
#define SEAM(k) do { if (IN(k) && IN((k) + 1)) xcd_barrier(bar); } while (0)
template <int l>
__device__ __forceinline__ void layer_phases(const Frame& F, const int lo, const int hi, const XcdBarrier& bar) {
        const int pb = 1 + 5 * l;
        if (IN(pb)) {
            PHASE_ARGS();
            pg8::Gemm g{FWS(bf16, WS_XB), FWS(bf16, WS_W1T) + (size_t)l * NP * D, T, NP, D}; pg8::StaticOrder S; S.init(T, NP, F.G, (int)blockIdx.x);
            pg8::EpiProj E{FWS(bf16, WS_PROJ), NP, FWS(float, WS_RSS), 1.f / D, EPS};
            pg8::gemm_phase<pg8::EpiProj, pg8::StaticOrder, true, true>(F.lds + RING_OFF, g, S, E);
        } SEAM(pb);
        if (IN(pb + 1)) { if (M1_FAST) m1_fast(F, l); else m1_naive(F, l); } SEAM(pb + 1);
        if (IN(pb + 2)) { if (M2_FAST) m2_fast(F); else m2_naive(F); } SEAM(pb + 2);
        if (IN(pb + 3)) { if (M3_FAST) m3_fast(F, l); else m3_naive(F, l); } SEAM(pb + 3);
        if (IN(pb + 4)) {
            PHASE_ARGS();
            pg8::Gemm g{FWS(bf16, WS_MIX), FWS(bf16, WS_W2T) + (size_t)l * D * D, T, D, D}; pg8::StaticOrder S; S.init(T, D, F.G, (int)blockIdx.x);
            pg8::EpiRes E{l == 0 ? FIN(I_X) : (const float*)ap->out, ap->out, FWS(bf16, WS_XB), FWS(float, WS_RSS), D};
            pg8::gemm_phase<pg8::EpiRes, pg8::StaticOrder, true, true>(F.lds + RING_OFF, g, S, E);
        } SEAM(pb + 4);
}
#undef IN
#undef SEAM
__global__ void __launch_bounds__(NTHR, 2) mk_fwd(Args args) {
    extern __shared__ __attribute__((aligned(16))) unsigned char lds[];
    Frame F;
    F.lds = (LAS unsigned char*)lds;
    F.MISC = (volatile LAS unsigned*)(F.lds + MISC_OFF);
    F.tid = threadIdx.x; F.lane = F.tid & 63; F.wave = __builtin_amdgcn_readfirstlane(F.tid >> 6);
    F.G = gridDim.x; { const int bx = blockIdx.x; F.vcu = (F.G % 8 == 0) ? (bx % 8) * (F.G / 8) + bx / 8 : bx; }
    F.ap = (const __attribute__((address_space(4))) Args*)__builtin_amdgcn_kernarg_segment_ptr();
    { PHASE_ARGS(); F.ctl = (gu32*)(ap->ws + WS_CTL); }
    for (int u = F.tid; u < (LDS_BYTES - LDSCTL_OFF) / 4; u += NTHR) ((LAS unsigned*)(F.lds + LDSCTL_OFF))[u] = 0u;
    __syncthreads();
    const int lo = args.ph_lo, hi = args.ph_hi;
    const bool multi = (hi - lo) > 1;
    XcdBarrier bar; bar.bar = (unsigned*)(F.ctl + CW_BAR); bar.x = 0; bar.st = nullptr;
    if (multi) bar = xcd_barrier_post((unsigned*)(F.ctl + CW_BAR), F.MISC + 8);
#define IN(k) (lo <= (k) && (k) < hi)
#define SEAM(k) do { if (IN(k) && IN((k) + 1)) xcd_barrier(bar); } while (0)
    if (IN(0)) { p0_prologue(F); } SEAM(0);
    layer_phases<0>(F, lo, hi, bar);
    layer_phases<1>(F, lo, hi, bar);
    if (IN(11)) fn_final(F);
#undef IN
#undef SEAM
}
#ifndef MK_N_LAUNCHES
#define MK_N_LAUNCHES 1
#endif
extern "C" void kernel_launch(void* const* d_in, const int* in_sizes, int n_in, void* d_out, int out_size, void* d_ws, size_t ws_size, hipStream_t stream) {
    static int grid = 0;
    if (grid == 0) {
        if (n_in != 17 || in_sizes[0] != T * D || out_size != T * D || ws_size < WS_END) { fprintf(stderr, "kernel_launch: unexpected shapes: n_in %d in0 %d out %d ws %zu (need %zu); nothing launched\n", n_in, n_in > 0 ? in_sizes[0] : -1, out_size, ws_size, (size_t)WS_END); grid = -1; return; }
        int dev = 0, cus = 0, per_cu = 0;
        if (hipGetDevice(&dev) != hipSuccess || hipDeviceGetAttribute(&cus, hipDeviceAttributeMultiprocessorCount, dev) != hipSuccess) { fprintf(stderr, "kernel_launch: device query failed\n"); grid = -1; return; }
        if (hipFuncSetAttribute((const void*)mk_fwd, hipFuncAttributeMaxDynamicSharedMemorySize, LDS_BYTES) != hipSuccess) { fprintf(stderr, "kernel_launch: hipFuncSetAttribute failed\n"); grid = -1; return; }
        if (hipOccupancyMaxActiveBlocksPerMultiprocessor(&per_cu, (const void*)mk_fwd, NTHR, LDS_BYTES) != hipSuccess || per_cu < 1) fprintf(stderr, "kernel_launch: note: occupancy query reports %d workgroups per CU\n", per_cu);
        (void)hipGetLastError();
        grid = cus;
    }
    if (grid < 0) return;
    if (hipMemsetAsync((char*)d_ws + WS_CTL, 0, CTL_ZERO_BYTES, stream) != hipSuccess) { fprintf(stderr, "kernel_launch: hipMemsetAsync failed\n"); return; }
    Args a{};
    for (int i = 0; i < 17; ++i) a.in[i] = (const float*)d_in[i];
    a.out = (float*)d_out; a.ws = (unsigned char*)d_ws;
    if (MK_N_LAUNCHES == 1) { a.ph_lo = 0; a.ph_hi = N_PHASES; a.li = 0; hipLaunchKernelGGL(mk_fwd, dim3(grid), dim3(NTHR), LDS_BYTES, stream, a); }
    else for (int li = 0; li < N_PHASES; ++li) { a.ph_lo = li; a.ph_hi = li + 1; a.li = li; hipLaunchKernelGGL(mk_fwd, dim3(grid), dim3(NTHR), LDS_BYTES, stream, a); }
    const hipError_t le = hipPeekAtLastError();
    if (le != hipSuccess) fprintf(stderr, "kernel_launch: launch failed: %s (grid %d x %d threads, %d B LDS)\n", hipGetErrorName(le), grid, NTHR, LDS_BYTES);
}
```
